# Optimizing an MI355X kernel written in HIP

```python
import math
import jax, jax.numpy as jnp
from jax import lax
import numpy as np

D_MODEL = 1024
BATCH = 4
SEQ = 4096
DEPTH = 2

FOURIER_GROUPS = 4
FOURIER_GROUP_DIM = D_MODEL // 8
FOURIER_WIDTH = FOURIER_GROUPS * FOURIER_GROUP_DIM
DIFF_HEADS = 4
DIFF_QK_DIM = D_MODEL // 16
DIFF_V_DIM = 2 * DIFF_QK_DIM
DIFF_WIDTH = DIFF_HEADS * DIFF_V_DIM
DIFF_QK_WIDTH = DIFF_HEADS * 2 * DIFF_QK_DIM
EVEN_IN_WIDTH = FOURIER_WIDTH + 2 * DIFF_QK_WIDTH + DIFF_WIDTH
EVEN_MIX_WIDTH = FOURIER_WIDTH + DIFF_WIDTH
Q_BLOCK = 128
REL_BUCKETS = 32
REL_MAX_DIST = 128
SGU_CHUNK = 128
SGU_GROUPS = 8
SGU_WIDTH = D_MODEL
SGU_GROUP_DIM = SGU_WIDTH // SGU_GROUPS
D_FF = ((-(-8 * D_MODEL // 3) + 255) // 256) * 256
RMS_EPS = 1e-6
N_EVEN = (DEPTH + 1) // 2
N_ODD = DEPTH // 2

kernel_name = 'hybrid_fourier_diffattn_sgu_encoder'


def rms_norm(x, g):
    xf = x.astype(jnp.float32)
    y = xf * lax.rsqrt(jnp.mean(xf * xf, axis=-1, keepdims=True) + RMS_EPS)
    return (y * g.astype(jnp.float32)).astype(x.dtype)


def t5_bucket(rel):
    half = REL_BUCKETS // 2
    max_exact = half // 2
    ret = (rel > 0).astype(jnp.int32) * half
    n = jnp.abs(rel)
    nf = jnp.maximum(n, 1).astype(jnp.float32)
    large = max_exact + (jnp.log(nf / max_exact) / math.log(REL_MAX_DIST / max_exact)
                         * (half - max_exact)).astype(jnp.int32)
    large = jnp.minimum(large, half - 1)
    return ret + jnp.where(n < max_exact, n, large)


def fourier_mix(z):
    b, s, _ = z.shape
    zg = z.astype(jnp.float32).reshape(b, s, FOURIER_GROUPS, FOURIER_GROUP_DIM)
    f = jnp.fft.fftn(zg, axes=(1, 3), norm='ortho').real
    return f.reshape(b, s, FOURIER_WIDTH).astype(z.dtype)


def diff_attention(q, k, v, rel_table, lam, lam_init, subln_g):
    b, s = q.shape[0], q.shape[1]
    nb = s // Q_BLOCK
    qb = (q * (DIFF_QK_DIM ** -0.5)).reshape(b, nb, Q_BLOCK, DIFF_HEADS, 2, DIFF_QK_DIM)
    qb = jnp.moveaxis(qb, 1, 0)
    kpos = jnp.arange(s, dtype=jnp.int32)

    def one_block(args):
        qi, bi = args
        qpos = bi * Q_BLOCK + jnp.arange(Q_BLOCK, dtype=jnp.int32)
        bias = rel_table[t5_bucket(kpos[None, :] - qpos[:, None])]
        bias = jnp.transpose(bias, (2, 0, 1)).astype(jnp.float32)
        logits = jnp.einsum('bqhjd,bkhjd->bhjqk', qi, k).astype(jnp.float32)
        p = jax.nn.softmax(logits + bias[None, :, None], axis=-1)
        a = p[:, :, 0] - lam * p[:, :, 1]
        return jnp.einsum('bhqk,bkhe->bqhe', a.astype(v.dtype), v)

    o = lax.map(one_block, (qb, jnp.arange(nb, dtype=jnp.int32)))
    o = jnp.moveaxis(o, 0, 1).reshape(b, s, DIFF_HEADS, DIFF_V_DIM)
    o = rms_norm(o, subln_g) * (1.0 - lam_init)
    return o.reshape(b, s, DIFF_WIDTH)


def even_mixer(h, w_in, w_out, rel_table, lambdas, subln_g, lam_init):
    b, s, _ = h.shape
    z = h @ w_in
    zf = z[..., :FOURIER_WIDTH]
    zq = z[..., FOURIER_WIDTH:FOURIER_WIDTH + DIFF_QK_WIDTH]
    zk = z[..., FOURIER_WIDTH + DIFF_QK_WIDTH:FOURIER_WIDTH + 2 * DIFF_QK_WIDTH]
    zv = z[..., FOURIER_WIDTH + 2 * DIFF_QK_WIDTH:]
    f = fourier_mix(zf)
    q = zq.reshape(b, s, DIFF_HEADS, 2, DIFF_QK_DIM)
    k = zk.reshape(b, s, DIFF_HEADS, 2, DIFF_QK_DIM)
    v = zv.reshape(b, s, DIFF_HEADS, DIFF_V_DIM)
    lf = lambdas.astype(jnp.float32)
    lam = jnp.exp(jnp.sum(lf[0] * lf[1])) - jnp.exp(jnp.sum(lf[2] * lf[3])) + lam_init
    a = diff_attention(q, k, v, rel_table, lam, lam_init, subln_g)
    return jnp.concatenate([f, a], axis=-1) @ w_out


def odd_mixer(h, w_uv, v_norm_g, w_s, b_s, w_out):
    b, s, _ = h.shape
    z = jax.nn.gelu(h @ w_uv, approximate=False)
    u = z[..., :SGU_WIDTH]
    v = rms_norm(z[..., SGU_WIDTH:], v_norm_g)
    nc = s // SGU_CHUNK
    vc = v.reshape(b, nc, SGU_CHUNK, SGU_GROUPS, SGU_GROUP_DIM)
    sv = jnp.einsum('gpq,bnqgc->bnpgc', w_s, vc) + jnp.transpose(b_s)[None, None, :, :, None]
    y = u * sv.reshape(b, s, SGU_WIDTH)
    return y @ w_out


def swiglu(h, w1, w3, w2):
    return (jax.nn.silu(h @ w1) * (h @ w3)) @ w2


def setup_inputs(seed: int = 0) -> dict:
    key = jax.random.key(seed)
    ks = jax.random.split(key, 20)
    f32 = jnp.float32
    nrm = lambda k, shape, scale: jax.random.normal(k, shape, f32) * scale
    gain = lambda k, shape: 1.0 + 0.02 * jax.random.normal(k, shape, f32)
    return {
        'x': jax.random.normal(ks[0], (BATCH, SEQ, D_MODEL), f32),
        'rel_bias_table': nrm(ks[1], (REL_BUCKETS, DIFF_HEADS), 0.5),
        'norm_mix_g': gain(ks[2], (DEPTH, D_MODEL)),
        'norm_ffn_g': gain(ks[3], (DEPTH, D_MODEL)),
        'even_w_in': nrm(ks[4], (N_EVEN, D_MODEL, EVEN_IN_WIDTH), D_MODEL ** -0.5),
        'even_w_out': nrm(ks[5], (N_EVEN, EVEN_MIX_WIDTH, D_MODEL), EVEN_MIX_WIDTH ** -0.5),
        'diff_lambda': nrm(ks[6], (N_EVEN, 4, DIFF_QK_DIM), 0.1),
        'diff_subln_g': gain(ks[7], (N_EVEN, DIFF_V_DIM)),
        'odd_w_uv': nrm(ks[8], (N_ODD, D_MODEL, 2 * SGU_WIDTH), D_MODEL ** -0.5),
        'odd_v_norm_g': gain(ks[9], (N_ODD, SGU_WIDTH)),
        'odd_w_s': nrm(ks[10], (N_ODD, SGU_GROUPS, SGU_CHUNK, SGU_CHUNK), SGU_CHUNK ** -0.5),
        'odd_b_s': gain(ks[11], (N_ODD, SGU_GROUPS, SGU_CHUNK)),
        'odd_w_out': nrm(ks[12], (N_ODD, SGU_WIDTH, D_MODEL), SGU_WIDTH ** -0.5),
        'ffn_w1': nrm(ks[13], (DEPTH, D_MODEL, D_FF), D_MODEL ** -0.5),
        'ffn_w3': nrm(ks[14], (DEPTH, D_MODEL, D_FF), D_MODEL ** -0.5),
        'ffn_w2': nrm(ks[15], (DEPTH, D_FF, D_MODEL), D_FF ** -0.5),
        'final_norm_g': gain(ks[16], (D_MODEL,)),
    }


def reference(x, rel_bias_table, norm_mix_g, norm_ffn_g, even_w_in, even_w_out,
              diff_lambda, diff_subln_g, odd_w_uv, odd_v_norm_g, odd_w_s, odd_b_s,
              odd_w_out, ffn_w1, ffn_w3, ffn_w2, final_norm_g):
    h = x
    for i in range(DEPTH):
        hn = rms_norm(h, norm_mix_g[i])
        j = i // 2
        if i % 2 == 0:
            lam_init = 0.8 - 0.6 * math.exp(-0.3 * i)
            m = even_mixer(hn, even_w_in[j], even_w_out[j], rel_bias_table,
                           diff_lambda[j], diff_subln_g[j], lam_init)
        else:
            m = odd_mixer(hn, odd_w_uv[j], odd_v_norm_g[j], odd_w_s[j], odd_b_s[j],
                          odd_w_out[j])
        h = h + m
        hn = rms_norm(h, norm_ffn_g[i])
        h = h + swiglu(hn, ffn_w1[i], ffn_w3[i], ffn_w2[i])
    return rms_norm(h, final_norm_g)
```

```cpp
#include <hip/hip_runtime.h>
#include <hip/hip_bf16.h>
#include <cstdio>
#include <cstdint>
#include <cmath>

#define GAS __attribute__((address_space(1)))
#define LAS __attribute__((address_space(3)))
typedef unsigned short bf16;
typedef unsigned v4u __attribute__((ext_vector_type(4)));
typedef float f32x4 __attribute__((ext_vector_type(4)));
typedef short bf16x8 __attribute__((ext_vector_type(8)));

constexpr int NB = 4, SEQ = 4096, D = 1024, M = NB * SEQ;
constexpr int FF = 2816, NQKV = 1536, NMIX = 1536, NUV = 2048;
constexpr float RMS_EPS = 1e-6f;
constexpr float LOG2E = 1.4426950408889634f;
constexpr float C2 = 0.125f * LOG2E;
constexpr float LAM_INIT0 = 0.2f;
constexpr float DFT_SCALE = 0.0013810679320049757f;

constexpr size_t MiB = 1u << 20;
constexpr size_t WS_CTL = 0, CTL_ZERO_BYTES = 1 * MiB;
constexpr size_t WS_SSQ = 1 * MiB;
constexpr size_t WS_RSTD0 = 7 * MiB;
constexpr size_t WS_WS = 7 * MiB + 512 * 1024;
constexpr size_t WS_WQKV = 8 * MiB;
constexpr size_t WS_WF = 11 * MiB;
constexpr size_t WS_WO0 = 12 * MiB;
constexpr size_t WS_WUV = 15 * MiB;
constexpr size_t WS_WO1 = 19 * MiB;
constexpr size_t WS_W13 = 21 * MiB;
constexpr size_t WS_W2 = 43 * MiB;
constexpr size_t WS_XB = 56 * MiB;
constexpr size_t WS_R1 = 88 * MiB;
constexpr size_t WS_OSC = WS_R1 + 48 * MiB;
constexpr size_t WS_R2 = 176 * MiB;
constexpr size_t WS_END = 240 * MiB;
constexpr size_t OUT_QKV = 0, OUT_ZFT = 48 * MiB;

__device__ __forceinline__ unsigned f2bf(float f) { unsigned u = __builtin_bit_cast(unsigned, f); return (u + 0x7fffu + ((u >> 16) & 1u)) >> 16; }
__device__ __forceinline__ unsigned pk2(float lo, float hi) { return f2bf(lo) | (f2bf(hi) << 16); }
__device__ __forceinline__ float bf2f(bf16 h) { return __builtin_bit_cast(float, (unsigned)h << 16); }
__device__ __forceinline__ float wave_sum(float v) {
#pragma unroll
    for (int o = 1; o < 64; o <<= 1) v += __shfl_xor(v, o);
    return v;
}
__device__ __forceinline__ float rstd_from(const float* ssqp, int row) {
    const f32x4* p = (const f32x4*)(ssqp + (size_t)row * 16);
    const f32x4 a = p[0], b = p[1], c = p[2], d = p[3];
    const float s = ((a.x + a.y) + (a.z + a.w)) + ((b.x + b.y) + (b.z + b.w)) + ((c.x + c.y) + (c.z + c.w)) + ((d.x + d.y) + (d.z + d.w));
    return 1.0f / sqrtf(s * (1.0f / 1024.0f) + RMS_EPS);
}
__device__ __forceinline__ float gelu_erf(float x) { return 0.5f * x * (1.0f + erff(x * 0.70710678118654752f)); }
__device__ __forceinline__ float silu_f(float x) { return x / (1.0f + __expf(-x)); }

__device__ __forceinline__ int t5_bucket(int rel) {
    const int ret = rel > 0 ? 16 : 0; const int n = rel < 0 ? -rel : rel;
    if (n < 8) return ret + n;
    const float nf = (float)n;
    int large = 8 + (int)(logf(nf / 8.0f) / 2.772588722239781f * 8.0f);
    large = large < 15 ? large : 15;
    return ret + large;
}

struct Unit { int pm, pn; long ao, bo; };
struct GemmD { const bf16* A; const bf16* Bt; int lda, ldb, K, nN; };

struct EpiQKV {
    bf16* O; const float* rstd;
    __device__ __forceinline__ void elem(const Unit& u, int lr, int lc, float a) const {
        const int row = u.pm * 256 + lr, col = u.pn * 256 + lc;
        O[(size_t)row * NQKV + col] = (bf16)f2bf(a * rstd[row] * (col < 512 ? C2 : 1.0f));
    }
};
struct EpiZfT {
    bf16* O; const float* rstd;
    __device__ __forceinline__ void elem(const Unit& u, int lr, int lc, float a) const {
        const int f = u.pm * 256 + lr, t = u.pn * 256 + lc;
        O[(size_t)f * M + t] = (bf16)f2bf(a * rstd[t]);
    }
};
struct EpiDft {
    bf16* O;
    __device__ __forceinline__ void elem(const Unit& u, int lr, int lc, float a) const {
        const int r = u.pm * 256 + lr, b = u.pn >> 1;
        const int row = b * SEQ + (r & 4095), col = (r >= 4096 ? 512 : 0) + (u.pn & 1) * 256 + lc;
        O[(size_t)row * NMIX + col] = (bf16)f2bf(a);
    }
};
struct EpiResid {
    const float* res; float* out; bf16* xb; float* ssqp;
    __device__ __forceinline__ void elem(const Unit& u, int lr, int lc, float a) const {
        const size_t i = (size_t)(u.pm * 256 + lr) * D + u.pn * 256 + lc;
        const float v = res[i] + a; out[i] = v; xb[i] = (bf16)f2bf(v);
    }
};
struct EpiFfnUp {
    bf16* O; const float* ssqp;
    __device__ __forceinline__ void elem2(const Unit& u, int lr, int lc, float a1, float a3) const {
        const int row = u.pm * 256 + lr; const float r = rstd_from(ssqp, row);
        O[(size_t)row * FF + u.pn * 128 + lc] = (bf16)f2bf(silu_f(a1 * r) * (a3 * r));
    }
};
struct EpiUV {
    bf16* O; const float* ssqp; float* ssqv;
    __device__ __forceinline__ void elem(const Unit& u, int lr, int lc, float a) const {
        const int row = u.pm * 256 + lr; const float r = rstd_from(ssqp, row);
        O[(size_t)row * NUV + u.pn * 256 + lc] = (bf16)f2bf(gelu_erf(a * r));
    }
};

__device__ __forceinline__ Unit unit_std(int idx, int nN, int lda, int ldb) { Unit u; u.pm = idx / nN; u.pn = idx % nN; u.ao = (long)u.pm * 256 * lda * 2; u.bo = (long)u.pn * 256 * ldb * 2; return u; }
__device__ __forceinline__ Unit unit_dft(int idx) { Unit u; u.pm = idx / 8; u.pn = idx % 8; u.ao = (long)u.pm * 256 * 4096 * 2; u.bo = ((long)(u.pn & 1) * 256 * M + (long)(u.pn >> 1) * SEQ) * 2; return u; }

template <class Epi, int MODE  >
__global__ __launch_bounds__(256) void naive_gemm(GemmD g, Epi E) {
    const int nN = g.nN;
    constexpr int SUBS = (MODE == 2) ? 8 : 16;
    const int uidx = blockIdx.x / SUBS, sub = blockIdx.x % SUBS;
    const Unit u = (MODE == 1) ? unit_dft(uidx) : unit_std(uidx, nN, g.lda, g.ldb);
    const int w = threadIdx.x >> 6, l = threadIdx.x & 63, wm = w >> 1, wn = w & 1, lr16 = l & 15, q = l >> 4;
    const int sm = (MODE == 2) ? (sub >> 1) : (sub >> 2), sn = (MODE == 2) ? (sub & 1) : (sub & 3);
    const char* Ab = (const char*)g.A + u.ao; const char* Bb = (const char*)g.Bt + u.bo;
    f32x4 acc[2][2] = {}, acc3[2][2] = {};
    for (int k0 = 0; k0 < g.K; k0 += 32) {
        bf16x8 a[2], b[2], b3[2];
#pragma unroll
        for (int i = 0; i < 2; ++i) a[i] = *(const bf16x8*)(Ab + ((size_t)(sm * 64 + wm * 32 + i * 16 + lr16) * g.lda + k0 + 8 * q) * 2);
#pragma unroll
        for (int j = 0; j < 2; ++j) {
            const int br = sn * 64 + wn * 32 + j * 16 + lr16;
            b[j] = *(const bf16x8*)(Bb + ((size_t)br * g.ldb + k0 + 8 * q) * 2);
            if (MODE == 2) b3[j] = *(const bf16x8*)(Bb + ((size_t)(br + 128) * g.ldb + k0 + 8 * q) * 2);
        }
#pragma unroll
        for (int i = 0; i < 2; ++i)
#pragma unroll
            for (int j = 0; j < 2; ++j) {
                acc[i][j] = __builtin_amdgcn_mfma_f32_16x16x32_bf16(a[i], b[j], acc[i][j], 0, 0, 0);
                if (MODE == 2) acc3[i][j] = __builtin_amdgcn_mfma_f32_16x16x32_bf16(a[i], b3[j], acc3[i][j], 0, 0, 0);
            }
    }
#pragma unroll
    for (int i = 0; i < 2; ++i)
#pragma unroll
        for (int j = 0; j < 2; ++j)
#pragma unroll
            for (int r = 0; r < 4; ++r) {
                const int lrow = sm * 64 + wm * 32 + i * 16 + q * 4 + r, lcol = sn * 64 + wn * 32 + j * 16 + lr16;
                if constexpr (MODE == 2) E.elem2(u, lrow, lcol, acc[i][j][r], acc3[i][j][r]); else E.elem(u, lrow, lcol, acc[i][j][r]);
            }
}

template <bool BF> __global__ __launch_bounds__(256) void naive_ssq(const void* X, int ld, int c0, float* ssqp) {
    const int row = blockIdx.x * 4 + (threadIdx.x >> 6), lane = threadIdx.x & 63; float s = 0.f;
    for (int c = lane; c < 1024; c += 64) { float v; if (BF) v = bf2f(((const bf16*)X)[(size_t)row * ld + c0 + c]); else v = ((const float*)X)[(size_t)row * ld + c0 + c]; s += v * v; }
    s = wave_sum(s);
    if (lane < 16) ssqp[(size_t)row * 16 + lane] = lane == 0 ? s : 0.f;
}

__global__ __launch_bounds__(256) void naive_attn(const bf16* QKV, bf16* Mix, const float* rel_table, const float* lambdas, const float* subln_g) {
    __shared__ float s0[SEQ], s1[SEQ]; __shared__ float qv[128]; __shared__ float red[8]; __shared__ float tb[257]; __shared__ float part[256];
    const int tid = threadIdx.x, lane = tid & 63, w = tid >> 6;
    const int qpos = blockIdx.x % SEQ, h = (blockIdx.x / SEQ) % 4, b = blockIdx.x / (SEQ * 4);
    const size_t rowq = (size_t)b * SEQ + qpos;
    if (tid < 128) qv[tid] = bf2f(QKV[rowq * NQKV + h * 128 + tid]);
    for (int i = tid; i < 257; i += 256) tb[i] = rel_table[t5_bucket(i - 128) * 4 + h] * LOG2E;
    float lp = (tid < 64) ? lambdas[tid] * lambdas[64 + tid] : (tid < 128 ? 0.f : (tid < 192 ? lambdas[128 + tid - 128] * lambdas[192 + tid - 128] : 0.f));
    lp = wave_sum(lp); if (lane == 0) red[w] = lp;
    __syncthreads();
    const float lam = expf(red[0]) - expf(red[2]) + LAM_INIT0;
    __syncthreads();
    float m0 = -1e30f, m1 = -1e30f;
    for (int kk = tid; kk < SEQ; kk += 256) {
        const bf16* kr = QKV + ((size_t)b * SEQ + kk) * NQKV + 512 + h * 128;
        float a0 = 0.f, a1 = 0.f;
        for (int d = 0; d < 64; ++d) { a0 += qv[d] * bf2f(kr[d]); a1 += qv[64 + d] * bf2f(kr[64 + d]); }
        int idx = kk - qpos + 128; idx = idx < 0 ? 0 : (idx > 256 ? 256 : idx);
        a0 += tb[idx]; a1 += tb[idx];
        s0[kk] = a0; s1[kk] = a1; m0 = fmaxf(m0, a0); m1 = fmaxf(m1, a1);
    }
#pragma unroll
    for (int o = 1; o < 64; o <<= 1) { m0 = fmaxf(m0, __shfl_xor(m0, o)); m1 = fmaxf(m1, __shfl_xor(m1, o)); }
    __syncthreads();
    if (lane == 0) { red[w] = m0; red[4 + w] = m1; }
    __syncthreads();
    m0 = fmaxf(fmaxf(red[0], red[1]), fmaxf(red[2], red[3])); m1 = fmaxf(fmaxf(red[4], red[5]), fmaxf(red[6], red[7]));
    __syncthreads();
    float l0 = 0.f, l1 = 0.f;
    for (int kk = tid; kk < SEQ; kk += 256) { const float p0 = exp2f(s0[kk] - m0), p1 = exp2f(s1[kk] - m1); s0[kk] = p0; s1[kk] = p1; l0 += p0; l1 += p1; }
    l0 = wave_sum(l0); l1 = wave_sum(l1);
    if (lane == 0) { red[w] = l0; red[4 + w] = l1; }
    __syncthreads();
    l0 = (red[0] + red[1]) + (red[2] + red[3]); l1 = (red[4] + red[5]) + (red[6] + red[7]);
    const float i0 = 1.0f / l0, i1 = lam / l1;
    for (int kk = tid; kk < SEQ; kk += 256) s0[kk] = s0[kk] * i0 - s1[kk] * i1;
    __syncthreads();
    const int e = tid & 127, half = tid >> 7; float o = 0.f;
    for (int kk = half * (SEQ / 2); kk < (half + 1) * (SEQ / 2); ++kk) o += s0[kk] * bf2f(QKV[((size_t)b * SEQ + kk) * NQKV + 1024 + h * 128 + e]);
    part[tid] = o;
    __syncthreads();
    if (tid < 128) {
        o = part[tid] + part[tid + 128];
        float sq = wave_sum(o * o);
        if (lane == 0) red[w] = sq;
    }
    __syncthreads();
    if (tid < 128) {
        const float r = 1.0f / sqrtf((red[0] + red[1]) * (1.0f / 128.0f) + RMS_EPS);
        Mix[rowq * NMIX + 1024 + h * 128 + e] = (bf16)f2bf(o * r * subln_g[e] * (1.0f - LAM_INIT0));
    }
}

__global__ __launch_bounds__(128) void naive_sgu(const bf16* UV, const bf16* Wsb, const float* b_s, const float* v_norm_g, const float* ssqv, bf16* Y) {
    const int p = blockIdx.x & 127, g = (blockIdx.x >> 7) & 7, ch = blockIdx.x >> 10, c = threadIdx.x;
    const int col = g * 128 + c; const float gv = v_norm_g[col];
    float acc = 0.f;
    for (int q = 0; q < 128; ++q) {
        const int row = ch * 128 + q;
        const float vn = bf2f((bf16)f2bf(bf2f(UV[(size_t)row * NUV + 1024 + col]) * rstd_from(ssqv, row) * gv));
        acc += bf2f(Wsb[(g * 128 + p) * 128 + q]) * vn;
    }
    const int row = ch * 128 + p;
    const float sv = acc + b_s[g * 128 + p];
    Y[(size_t)row * D + col] = (bf16)f2bf(bf2f(UV[(size_t)row * NUV + col]) * sv);
}

__global__ __launch_bounds__(256) void final_norm(float* out, const float* ssqp, const float* g) {
    const int row = blockIdx.x * 4 + (threadIdx.x >> 6), lane = threadIdx.x & 63;
    const float r = rstd_from(ssqp, row);
    f32x4* o = (f32x4*)(out + (size_t)row * D) + lane; const f32x4* gg = (const f32x4*)g + lane;
#pragma unroll
    for (int j = 0; j < 4; ++j) { f32x4 v = o[64 * j]; const f32x4 gv = gg[64 * j]; v = v * r * gv; o[64 * j] = v; }
}

struct ProArgs { const float* in[17]; unsigned char* ws; float* out; };
__device__ __forceinline__ void tr_item(const float* W, int ldsrc, int k0, int n0, bf16* WT, int lddst, int rowbase, int kdst0, const float* gs, LAS float* scr, int lane) {
#pragma unroll 8
    for (int i = 0; i < 32; ++i) { const int kk = 2 * i + (lane >> 5); float v = W[(size_t)(k0 + kk) * ldsrc + n0 + (lane & 31)]; if (gs) v *= gs[k0 + kk]; scr[kk * 33 + (lane & 31)] = v; }
    asm volatile("s_waitcnt lgkmcnt(0)" ::: "memory");
    const int c = lane & 7;
#pragma unroll
    for (int j = 0; j < 4; ++j) { const int n = (lane >> 3) + 8 * j; const LAS float* s = scr + (8 * c) * 33 + n;
        v4u o; o.x = pk2(s[0 * 33], s[1 * 33]); o.y = pk2(s[2 * 33], s[3 * 33]); o.z = pk2(s[4 * 33], s[5 * 33]); o.w = pk2(s[6 * 33], s[7 * 33]);
        *(v4u*)(WT + (size_t)(rowbase + n) * lddst + kdst0 + 8 * c) = o; }
    asm volatile("s_waitcnt lgkmcnt(0)" ::: "memory");
}
__device__ __forceinline__ void prologue_body(const ProArgs& P, LAS unsigned char* lds, int gw, int NGW, int lane, int gtid, int NGT) {
    LAS float* scr = (LAS float*)(lds + (threadIdx.x >> 6) * 18432);
    unsigned char* ws = P.ws;
    const float* x = P.in[0]; const float* g_mix = P.in[2]; const float* g_ffn = P.in[3];
    const float* w_in = P.in[4]; const float* w_out0 = P.in[5]; const float* w_uv = P.in[8]; const float* w_s = P.in[10]; const float* w_out1 = P.in[12];
    const float* w1 = P.in[13]; const float* w3 = P.in[14]; const float* w2 = P.in[15];
    bf16* Wqkv = (bf16*)(ws + WS_WQKV); bf16* Wf = (bf16*)(ws + WS_WF); bf16* Wo0 = (bf16*)(ws + WS_WO0); bf16* Wuv = (bf16*)(ws + WS_WUV); bf16* Wo1 = (bf16*)(ws + WS_WO1);
    constexpr int I_FOLD = 2 * 4 * 32 * 4;
    constexpr int I_WIN = 16 * 64;
    constexpr int I_WO0 = 8 * 32;
    constexpr int I_WUV = 16 * 64, I_WO1 = 16 * 32;
    constexpr int I_W1 = 16 * 88, I_W2 = 44 * 32;
    constexpr int NITEMS = I_FOLD + I_WIN + I_WO0 + I_WUV + I_WO1 + 4 * I_W1 + 2 * I_W2;
    for (int it = gw; it < NITEMS; it += NGW) {
        int r = it;
        if (r < I_FOLD) {
            const int cq = r & 3, nb = (r >> 2) & 31, g = (r >> 7) & 3, part = r >> 9;
            LAS float* tab = scr + 128 * 32;
            for (int i = lane; i < 128 * 32; i += 64) scr[i] = w_out0[(size_t)(g * 128 + (i >> 5)) * D + nb * 32 + (i & 31)];
            for (int i = lane; i < 128; i += 64) tab[i] = part ? -__builtin_amdgcn_sinf((float)i * (1.0f / 128.0f)) : __builtin_amdgcn_cosf((float)i * (1.0f / 128.0f));
            asm volatile("s_waitcnt lgkmcnt(0)" ::: "memory");
            const int n = lane & 31, chalf = lane >> 5; float o[16];
#pragma unroll
            for (int ci = 0; ci < 16; ++ci) { const int c = cq * 32 + chalf * 16 + ci; float s = 0.f;
                for (int l = 0; l < 128; ++l) s += tab[(l * c) & 127] * scr[l * 32 + n];
                o[ci] = s * DFT_SCALE; }
            v4u o0, o1; o0.x = pk2(o[0], o[1]); o0.y = pk2(o[2], o[3]); o0.z = pk2(o[4], o[5]); o0.w = pk2(o[6], o[7]); o1.x = pk2(o[8], o[9]); o1.y = pk2(o[10], o[11]); o1.z = pk2(o[12], o[13]); o1.w = pk2(o[14], o[15]);
            bf16* dst = Wo0 + (size_t)(nb * 32 + n) * NMIX + part * 512 + g * 128 + cq * 32 + chalf * 16;
            *(v4u*)dst = o0; *(v4u*)(dst + 8) = o1;
            asm volatile("s_waitcnt lgkmcnt(0)" ::: "memory");
            continue; }
        r -= I_FOLD;
        if (r < I_WIN) { const int kb = r / 64, nb = r % 64, n0 = nb * 32;
            if (n0 < 512) tr_item(w_in, 2048, kb * 64, n0, Wf, D, n0, kb * 64, g_mix, scr, lane);
            else tr_item(w_in, 2048, kb * 64, n0, Wqkv, D, n0 - 512, kb * 64, g_mix, scr, lane);
            continue; }
        r -= I_WIN;
        if (r < I_WO0) { const int kb = r / 32, nb = r % 32; tr_item(w_out0, D, 512 + kb * 64, nb * 32, Wo0, NMIX, nb * 32, 1024 + kb * 64, nullptr, scr, lane); continue; }
        r -= I_WO0;
        if (r < I_WUV) { const int kb = r / 64, nb = r % 64; tr_item(w_uv, 2048, kb * 64, nb * 32, Wuv, D, nb * 32, kb * 64, g_mix + D, scr, lane); continue; }
        r -= I_WUV;
        if (r < I_WO1) { const int kb = r / 32, nb = r % 32; tr_item(w_out1, D, kb * 64, nb * 32, Wo1, D, nb * 32, kb * 64, nullptr, scr, lane); continue; }
        r -= I_WO1;
        if (r < 4 * I_W1) { const int which = r / I_W1, rr = r % I_W1, L = which >> 1, is3 = which & 1; const int kb = rr / 88, nb = rr % 88, n0 = nb * 32;
            const float* src = (is3 ? w3 : w1) + (size_t)L * D * FF; bf16* dst = (bf16*)(ws + WS_W13 + (size_t)L * 11 * MiB);
            tr_item(src, FF, kb * 64, n0, dst, D, (n0 / 128) * 256 + is3 * 128 + (n0 % 128), kb * 64, g_ffn + L * D, scr, lane); continue; }
        r -= 4 * I_W1;
        { const int L = r / I_W2, rr = r % I_W2; const int kb = rr / 32, nb = rr % 32;
            const float* src = w2 + (size_t)L * FF * D; bf16* dst = (bf16*)(ws + WS_W2 + (size_t)L * (11 * MiB / 2));
            tr_item(src, D, kb * 64, nb * 32, dst, FF, nb * 32, kb * 64, nullptr, scr, lane); }
    }
    bf16* XB = (bf16*)(ws + WS_XB); float* rstd0 = (float*)(ws + WS_RSTD0);
    for (int m = gw; m < M; m += NGW) {
        const f32x4* xr = (const f32x4*)(x + (size_t)m * D) + lane; f32x4 v[4]; float s = 0.f;
#pragma unroll
        for (int j = 0; j < 4; ++j) { v[j] = xr[64 * j]; s += (v[j].x * v[j].x + v[j].y * v[j].y) + (v[j].z * v[j].z + v[j].w * v[j].w); }
        s = wave_sum(s);
        unsigned long long* o8 = (unsigned long long*)(XB + (size_t)m * D) + lane;
#pragma unroll
        for (int j = 0; j < 4; ++j) o8[64 * j] = (unsigned long long)pk2(v[j].x, v[j].y) | ((unsigned long long)pk2(v[j].z, v[j].w) << 32);
        if (lane == 0) rstd0[m] = 1.0f / sqrtf(s * (1.0f / 1024.0f) + RMS_EPS);
    }
    bf16* Dm = (bf16*)(ws + WS_R2);
    for (int i = gtid; i < 8192 * 512; i += NGT) {
        const int r = i >> 9, s0 = (i & 511) * 8, rr = r & 4095; float v[8];
#pragma unroll
        for (int j = 0; j < 8; ++j) { const float ph = (float)((rr * (s0 + j)) & 4095) * (1.0f / 4096.0f); v[j] = r < 4096 ? __builtin_amdgcn_cosf(ph) : __builtin_amdgcn_sinf(ph); }
        v4u o; o.x = pk2(v[0], v[1]); o.y = pk2(v[2], v[3]); o.z = pk2(v[4], v[5]); o.w = pk2(v[6], v[7]);
        *(v4u*)(Dm + (size_t)r * 4096 + s0) = o;
    }
    bf16* Wsb = (bf16*)(ws + WS_WS);
    for (int i = gtid; i < 8 * 128 * 128 / 8; i += NGT) { const f32x4 a = ((const f32x4*)w_s)[2 * i], b = ((const f32x4*)w_s)[2 * i + 1];
        v4u o; o.x = pk2(a.x, a.y); o.y = pk2(a.z, a.w); o.z = pk2(b.x, b.y); o.w = pk2(b.z, b.w); ((v4u*)Wsb)[i] = o; }
}
__global__ __launch_bounds__(512, 2) void prologue_kernel(ProArgs P) {
    extern __shared__ __attribute__((aligned(16))) unsigned char lds[];
    const int wave = threadIdx.x >> 6, lane = threadIdx.x & 63;
    prologue_body(P, (LAS unsigned char*)lds, blockIdx.x * 8 + wave, gridDim.x * 8, lane, blockIdx.x * 512 + threadIdx.x, gridDim.x * 512);
}

extern "C" void kernel_launch(void* const* d_in, const int* in_sizes, int n_in, void* d_out, int out_size, void* d_ws, size_t ws_size, hipStream_t stream) {
    static int ok = 0;
    if (ok == 0) {
        if (n_in != 17 || in_sizes[0] != M * D || out_size != M * D || ws_size < WS_END) { fprintf(stderr, "kernel_launch: unexpected shapes (n_in %d, in0 %d, out %d, ws %zu)\n", n_in, n_in > 0 ? in_sizes[0] : -1, out_size, ws_size); ok = -1; return; }
        if (hipFuncSetAttribute((const void*)prologue_kernel, hipFuncAttributeMaxDynamicSharedMemorySize, 147456) != hipSuccess) { fprintf(stderr, "kernel_launch: hipFuncSetAttribute failed\n"); ok = -1; return; }
        ok = 1;
    }
    if (ok < 0) return;
    unsigned char* ws = (unsigned char*)d_ws; float* out = (float*)d_out;
    ProArgs P{}; for (int i = 0; i < 17; ++i) P.in[i] = (const float*)d_in[i]; P.ws = ws; P.out = out;
    const float* x = P.in[0];
    float* ssq = (float*)(ws + WS_SSQ); auto SSQ = [&](int i) { return ssq + (size_t)i * M * 16; };
    const float* rstd0 = (const float*)(ws + WS_RSTD0);
    bf16* XB = (bf16*)(ws + WS_XB); bf16* QKV = (bf16*)((unsigned char*)d_out + OUT_QKV); bf16* ZfT = (bf16*)((unsigned char*)d_out + OUT_ZFT);
    bf16* Mix = (bf16*)(ws + WS_R1); bf16* G = (bf16*)(ws + WS_R1); bf16* UV = (bf16*)(ws + WS_R1); bf16* Y = (bf16*)(ws + WS_R2); bf16* Dm = (bf16*)(ws + WS_R2);
    bf16* Wqkv = (bf16*)(ws + WS_WQKV); bf16* Wf = (bf16*)(ws + WS_WF); bf16* Wo0 = (bf16*)(ws + WS_WO0); bf16* Wuv = (bf16*)(ws + WS_WUV); bf16* Wo1 = (bf16*)(ws + WS_WO1); bf16* Wsb = (bf16*)(ws + WS_WS);

    hipLaunchKernelGGL(prologue_kernel, dim3(256), dim3(512), 147456, stream, P);
    { GemmD g{XB, Wqkv, D, D, D, 6}; EpiQKV E{QKV, rstd0}; hipLaunchKernelGGL((naive_gemm<EpiQKV, 0>), dim3(64 * 6 * 16), dim3(256), 0, stream, g, E); }
    { GemmD g{Wf, XB, D, D, D, 64}; EpiZfT E{ZfT, rstd0}; hipLaunchKernelGGL((naive_gemm<EpiZfT, 0>), dim3(2 * 64 * 16), dim3(256), 0, stream, g, E); }
    { GemmD g{Dm, ZfT, 4096, M, 4096, 8}; EpiDft E{Mix}; hipLaunchKernelGGL((naive_gemm<EpiDft, 1>), dim3(256 * 16), dim3(256), 0, stream, g, E); }
    hipLaunchKernelGGL(naive_attn, dim3(NB * 4 * SEQ), dim3(256), 0, stream, (const bf16*)QKV, Mix, P.in[1], P.in[6], P.in[7]);
    { GemmD g{Mix, Wo0, NMIX, NMIX, NMIX, 4}; EpiResid E{x, out, XB, nullptr}; hipLaunchKernelGGL((naive_gemm<EpiResid, 0>), dim3(256 * 16), dim3(256), 0, stream, g, E); }
    hipLaunchKernelGGL(naive_ssq<false>, dim3(M / 4), dim3(256), 0, stream, (const void*)out, D, 0, SSQ(1));
    for (int L = 0; L < 2; ++L) {
        if (L == 1) {
            { GemmD g{XB, Wuv, D, D, D, 8}; EpiUV E{UV, SSQ(2), nullptr}; hipLaunchKernelGGL((naive_gemm<EpiUV, 0>), dim3(64 * 8 * 16), dim3(256), 0, stream, g, E); }
            hipLaunchKernelGGL(naive_ssq<true>, dim3(M / 4), dim3(256), 0, stream, (const void*)UV, NUV, 1024, SSQ(3));
            hipLaunchKernelGGL(naive_sgu, dim3(128 * 8 * 128), dim3(128), 0, stream, (const bf16*)UV, (const bf16*)Wsb, P.in[11], P.in[9], (const float*)SSQ(3), Y);
            { GemmD g{Y, Wo1, D, D, D, 4}; EpiResid E{out, out, XB, nullptr}; hipLaunchKernelGGL((naive_gemm<EpiResid, 0>), dim3(256 * 16), dim3(256), 0, stream, g, E); }
            hipLaunchKernelGGL(naive_ssq<false>, dim3(M / 4), dim3(256), 0, stream, (const void*)out, D, 0, SSQ(4));
        }
        const float* ssq_in = L == 0 ? SSQ(1) : SSQ(4); float* ssq_out = L == 0 ? SSQ(2) : SSQ(5);
        { GemmD g{XB, (const bf16*)(ws + WS_W13 + (size_t)L * 11 * MiB), D, D, D, 22}; EpiFfnUp E{G, ssq_in}; hipLaunchKernelGGL((naive_gemm<EpiFfnUp, 2>), dim3(64 * 22 * 8), dim3(256), 0, stream, g, E); }
        { GemmD g{G, (const bf16*)(ws + WS_W2 + (size_t)L * (11 * MiB / 2)), FF, FF, FF, 4}; EpiResid E{out, out, XB, nullptr}; hipLaunchKernelGGL((naive_gemm<EpiResid, 0>), dim3(256 * 16), dim3(256), 0, stream, g, E); }
        hipLaunchKernelGGL(naive_ssq<false>, dim3(M / 4), dim3(256), 0, stream, (const void*)out, D, 0, ssq_out);
    }
    hipLaunchKernelGGL(final_norm, dim3(M / 4), dim3(256), 0, stream, out, (const float*)SSQ(5), P.in[16]);
    const hipError_t le = hipPeekAtLastError();
    if (le != hipSuccess) fprintf(stderr, "kernel_launch: launch failed: %s\n", hipGetErrorName(le));
}
```

```cpp
#include <hip/hip_runtime.h>
#include <hip/hip_bf16.h>
#include <cstdio>
#include <cstdint>
#include <cmath>

#define GAS __attribute__((address_space(1)))
#define LAS __attribute__((address_space(3)))
typedef unsigned short bf16;
typedef unsigned v4u __attribute__((ext_vector_type(4)));
typedef float f32x4 __attribute__((ext_vector_type(4)));
typedef short bf16x8 __attribute__((ext_vector_type(8)));

constexpr int NB = 4, SEQ = 4096, D = 1024, M = NB * SEQ;
constexpr int FF = 2816, NQKV = 1536, NMIX = 1536, NUV = 2048;
constexpr float RMS_EPS = 1e-6f;
constexpr float LOG2E = 1.4426950408889634f;
constexpr float C2 = 0.125f * LOG2E;
constexpr float LAM_INIT0 = 0.2f;
constexpr float DFT_SCALE = 0.0013810679320049757f;

constexpr size_t MiB = 1u << 20;
constexpr size_t WS_CTL = 0, CTL_ZERO_BYTES = 1 * MiB;
constexpr size_t WS_SSQ = 1 * MiB;
constexpr size_t WS_RSTD0 = 7 * MiB;
constexpr size_t WS_WS = 7 * MiB + 512 * 1024;
constexpr size_t WS_WQKV = 8 * MiB;
constexpr size_t WS_WF = 11 * MiB;
constexpr size_t WS_WO0 = 12 * MiB;
constexpr size_t WS_WUV = 15 * MiB;
constexpr size_t WS_WO1 = 19 * MiB;
constexpr size_t WS_W13 = 21 * MiB;
constexpr size_t WS_W2 = 43 * MiB;
constexpr size_t WS_XB = 56 * MiB;
constexpr size_t WS_R1 = 88 * MiB;
constexpr size_t WS_OSC = WS_R1 + 48 * MiB;
constexpr size_t WS_R2 = 176 * MiB;
constexpr size_t WS_END = 240 * MiB;
constexpr size_t OUT_QKV = 0, OUT_ZFT = 48 * MiB;

__device__ __forceinline__ unsigned f2bf(float f) { unsigned u = __builtin_bit_cast(unsigned, f); return (u + 0x7fffu + ((u >> 16) & 1u)) >> 16; }
__device__ __forceinline__ unsigned pk2(float lo, float hi) { return f2bf(lo) | (f2bf(hi) << 16); }
__device__ __forceinline__ float bf2f(bf16 h) { return __builtin_bit_cast(float, (unsigned)h << 16); }
__device__ __forceinline__ float wave_sum(float v) {
#pragma unroll
    for (int o = 1; o < 64; o <<= 1) v += __shfl_xor(v, o);
    return v;
}
__device__ __forceinline__ float rstd_from(const float* ssqp, int row) {
    const f32x4* p = (const f32x4*)(ssqp + (size_t)row * 16);
    const f32x4 a = p[0], b = p[1], c = p[2], d = p[3];
    const float s = ((a.x + a.y) + (a.z + a.w)) + ((b.x + b.y) + (b.z + b.w)) + ((c.x + c.y) + (c.z + c.w)) + ((d.x + d.y) + (d.z + d.w));
    return 1.0f / sqrtf(s * (1.0f / 1024.0f) + RMS_EPS);
}
__device__ __forceinline__ float gelu_erf(float x) { return 0.5f * x * (1.0f + erff(x * 0.70710678118654752f)); }
__device__ __forceinline__ float gelu_as(float v) {
    const float av = fabsf(v), t = __builtin_amdgcn_rcpf(av * 0.2316418882f + 1.0f);
    float q = t * 0.5307027145f + (-0.7265760135f); q = q * t + 0.7107068705f; q = q * t + (-0.142248368f); q = q * t + 0.127414796f; q = q * t;
    const float e = __builtin_amdgcn_exp2f((v * v) * (-0.72134752044f));
    const float m = v * (q * e);
    return v < 0.f ? m : v - m;
}
__device__ __forceinline__ float silu_f(float x) { return x / (1.0f + __expf(-x)); }

__device__ __forceinline__ int t5_bucket(int rel) {
    const int ret = rel > 0 ? 16 : 0; const int n = rel < 0 ? -rel : rel;
    if (n < 8) return ret + n;
    const float nf = (float)n;
    int large = 8 + (int)(logf(nf / 8.0f) / 2.772588722239781f * 8.0f);
    large = large < 15 ? large : 15;
    return ret + large;
}

struct Unit { int pm, pn; long ao, bo; };
struct GemmD { const bf16* A; const bf16* Bt; int lda, ldb, K, nN; };

typedef f32x4 AccT[2][2][4][2];
__device__ __forceinline__ v4u pack8(const f32x4 a, const f32x4 b) { v4u w; w.x = pk2(a.x, a.y); w.y = pk2(a.z, a.w); w.z = pk2(b.x, b.y); w.w = pk2(b.z, b.w); return w; }
__device__ __forceinline__ void row_rstd8(const float* ssqp, int row0, int fq, float (&rs)[2][4]) {
#pragma unroll
    for (int ai = 0; ai < 2; ++ai)
#pragma unroll
        for (int m = 0; m < 4; ++m) { const f32x4 p = *(const f32x4*)(ssqp + (size_t)(row0 + ai * 128 + m * 16) * 16 + fq * 4);
            float s = (p.x + p.y) + (p.z + p.w); s += __shfl_xor(s, 16); s += __shfl_xor(s, 32); rs[ai][m] = 1.0f / sqrtf(s * (1.0f / 1024.0f) + RMS_EPS); }
}
struct EpiQKV {
    static constexpr bool PERM = true, AFTER_DRAIN = false;
    bf16* O; const float* rstd;
    __device__ __forceinline__ void elem(const Unit& u, int lr, int lc, float a) const {
        const int row = u.pm * 256 + lr, col = u.pn * 256 + lc;
        O[(size_t)row * NQKV + col] = (bf16)f2bf(a * rstd[row] * (col < 512 ? C2 : 1.0f));
    }
    __device__ __forceinline__ void operator()(const AccT& acc, const Unit& u, int wr, int wc, int fr, int fq) const {
        const int row0 = u.pm * 256 + wr * 64 + fr;
#pragma unroll
        for (int ai = 0; ai < 2; ++ai)
#pragma unroll
            for (int m = 0; m < 4; ++m) { const int row = row0 + ai * 128 + m * 16; const float r = rstd[row];
#pragma unroll
                for (int bj = 0; bj < 2; ++bj) { const int col0 = u.pn * 256 + bj * 128 + wc * 32 + 8 * fq; const float sc = r * (col0 < 512 ? C2 : 1.0f);
                    *(v4u*)(O + (size_t)row * NQKV + col0) = pack8(acc[ai][bj][m][0] * sc, acc[ai][bj][m][1] * sc); } }
    }
};
struct EpiZfT {
    static constexpr bool PERM = true, AFTER_DRAIN = false;
    bf16* O; const float* rstd;
    __device__ __forceinline__ void elem(const Unit& u, int lr, int lc, float a) const {
        const int f = u.pm * 256 + lr, t = u.pn * 256 + lc;
        O[(size_t)f * M + t] = (bf16)f2bf(a * rstd[t]);
    }
    __device__ __forceinline__ void operator()(const AccT& acc, const Unit& u, int wr, int wc, int fr, int fq) const {
        const int row0 = u.pm * 256 + wr * 64 + fr;
#pragma unroll
        for (int bj = 0; bj < 2; ++bj) { const int col0 = u.pn * 256 + bj * 128 + wc * 32 + 8 * fq;
            const f32x4 ra = *(const f32x4*)(rstd + col0), rb = *(const f32x4*)(rstd + col0 + 4);
#pragma unroll
            for (int ai = 0; ai < 2; ++ai)
#pragma unroll
                for (int m = 0; m < 4; ++m) { const int row = row0 + ai * 128 + m * 16;
                    *(v4u*)(O + (size_t)row * M + col0) = pack8(acc[ai][bj][m][0] * ra, acc[ai][bj][m][1] * rb); } }
    }
};
struct EpiDft {
    static constexpr bool PERM = true, AFTER_DRAIN = false;
    bf16* O;
    __device__ __forceinline__ void elem(const Unit& u, int lr, int lc, float a) const {
        const int r = u.pm * 256 + lr, b = u.pn >> 1;
        const int row = b * SEQ + (r & 4095), col = (r >= 4096 ? 512 : 0) + (u.pn & 1) * 256 + lc;
        O[(size_t)row * NMIX + col] = (bf16)f2bf(a);
    }
    __device__ __forceinline__ void operator()(const AccT& acc, const Unit& u, int wr, int wc, int fr, int fq) const {
        const int r0 = u.pm * 256 + wr * 64 + fr, b = u.pn >> 1, colbase = (u.pm >= 16 ? 512 : 0) + (u.pn & 1) * 256 + wc * 32 + 8 * fq;
#pragma unroll
        for (int ai = 0; ai < 2; ++ai)
#pragma unroll
            for (int m = 0; m < 4; ++m) { const int row = b * SEQ + ((r0 + ai * 128 + m * 16) & 4095);
#pragma unroll
                for (int bj = 0; bj < 2; ++bj) *(v4u*)(O + (size_t)row * NMIX + colbase + bj * 128) = pack8(acc[ai][bj][m][0], acc[ai][bj][m][1]); }
    }
};
struct EpiResid {
    static constexpr bool PERM = true, AFTER_DRAIN = false;
    const float* res; float* out; bf16* xb; float* ssqp;
    __device__ __forceinline__ void elem(const Unit& u, int lr, int lc, float a) const {
        const size_t i = (size_t)(u.pm * 256 + lr) * D + u.pn * 256 + lc;
        const float v = res[i] + a; out[i] = v; xb[i] = (bf16)f2bf(v);
    }
    __device__ __forceinline__ void operator()(const AccT& acc, const Unit& u, int wr, int wc, int fr, int fq) const {
        const int row0 = u.pm * 256 + wr * 64 + fr;
#pragma unroll
        for (int ai = 0; ai < 2; ++ai)
#pragma unroll
            for (int m = 0; m < 4; ++m) { const int row = row0 + ai * 128 + m * 16; float sq = 0.f;
#pragma unroll
                for (int bj = 0; bj < 2; ++bj) { const size_t off = (size_t)row * D + u.pn * 256 + bj * 128 + wc * 32 + 8 * fq;
                    const f32x4 v0 = *(const f32x4*)(res + off) + acc[ai][bj][m][0], v1 = *(const f32x4*)(res + off + 4) + acc[ai][bj][m][1];
                    *(f32x4*)(out + off) = v0; *(f32x4*)(out + off + 4) = v1; *(v4u*)(xb + off) = pack8(v0, v1);
                    sq += ((v0.x * v0.x + v0.y * v0.y) + (v0.z * v0.z + v0.w * v0.w)) + ((v1.x * v1.x + v1.y * v1.y) + (v1.z * v1.z + v1.w * v1.w)); }
                sq += __shfl_xor(sq, 16); sq += __shfl_xor(sq, 32);
                if (fq == 0) ssqp[(size_t)row * 16 + u.pn * 4 + wc] = sq; }
    }
};
struct EpiFfnUp {
    static constexpr bool PERM = true, AFTER_DRAIN = false;
    bf16* O; const float* ssqp;
    __device__ __forceinline__ void elem2(const Unit& u, int lr, int lc, float a1, float a3) const {
        const int row = u.pm * 256 + lr; const float r = rstd_from(ssqp, row);
        O[(size_t)row * FF + u.pn * 128 + lc] = (bf16)f2bf(silu_f(a1 * r) * (a3 * r));
    }
    __device__ __forceinline__ void operator()(const AccT& acc, const Unit& u, int wr, int wc, int fr, int fq) const {
        const int row0 = u.pm * 256 + wr * 64 + fr; float rs[2][4]; row_rstd8(ssqp, row0, fq, rs);
#pragma unroll
        for (int ai = 0; ai < 2; ++ai)
#pragma unroll
            for (int m = 0; m < 4; ++m) { const int row = row0 + ai * 128 + m * 16; const float r = rs[ai][m]; f32x4 gq[2];
#pragma unroll
                for (int n = 0; n < 2; ++n) { const f32x4 a1 = acc[ai][0][m][n] * r, a3 = acc[ai][1][m][n] * r;
                    gq[n].x = silu_f(a1.x) * a3.x; gq[n].y = silu_f(a1.y) * a3.y; gq[n].z = silu_f(a1.z) * a3.z; gq[n].w = silu_f(a1.w) * a3.w; }
                *(v4u*)(O + (size_t)row * FF + u.pn * 128 + wc * 32 + 8 * fq) = pack8(gq[0], gq[1]); }
    }
};
struct EpiUV {
    static constexpr bool PERM = true, AFTER_DRAIN = false;
    bf16* O; const float* ssqp; float* ssqv;
    __device__ __forceinline__ void elem(const Unit& u, int lr, int lc, float a) const {
        const int row = u.pm * 256 + lr; const float r = rstd_from(ssqp, row);
        O[(size_t)row * NUV + u.pn * 256 + lc] = (bf16)f2bf(gelu_erf(a * r));
    }
    __device__ __forceinline__ void operator()(const AccT& acc, const Unit& u, int wr, int wc, int fr, int fq) const {
        const int row0 = u.pm * 256 + wr * 64 + fr; float rs[2][4]; row_rstd8(ssqp, row0, fq, rs);
#pragma unroll
        for (int ai = 0; ai < 2; ++ai)
#pragma unroll
            for (int m = 0; m < 4; ++m) { const int row = row0 + ai * 128 + m * 16; const float r = rs[ai][m]; float sq = 0.f;
#pragma unroll
                for (int bj = 0; bj < 2; ++bj) { f32x4 v[2];
#pragma unroll
                    for (int n = 0; n < 2; ++n) { const f32x4 a = acc[ai][bj][m][n] * r; v[n].x = gelu_as(a.x); v[n].y = gelu_as(a.y); v[n].z = gelu_as(a.z); v[n].w = gelu_as(a.w);
                        sq += (v[n].x * v[n].x + v[n].y * v[n].y) + (v[n].z * v[n].z + v[n].w * v[n].w); }
                    *(v4u*)(O + (size_t)row * NUV + u.pn * 256 + bj * 128 + wc * 32 + 8 * fq) = pack8(v[0], v[1]); }
                if (u.pn >= 4) { sq += __shfl_xor(sq, 16); sq += __shfl_xor(sq, 32); if (fq == 0) ssqv[(size_t)row * 16 + (u.pn - 4) * 4 + wc] = sq; } }
    }
};

__device__ __forceinline__ Unit unit_std(int idx, int nN, int lda, int ldb) { Unit u; u.pm = idx / nN; u.pn = idx % nN; u.ao = (long)u.pm * 256 * lda * 2; u.bo = (long)u.pn * 256 * ldb * 2; return u; }
__device__ __forceinline__ Unit unit_dft(int idx) { Unit u; u.pm = idx / 8; u.pn = idx % 8; u.ao = (long)u.pm * 256 * 4096 * 2; u.bo = ((long)(u.pn & 1) * 256 * M + (long)(u.pn >> 1) * SEQ) * 2; return u; }

template <class Epi, int MODE  >
__global__ __launch_bounds__(256) void naive_gemm(GemmD g, Epi E) {
    const int nN = g.nN;
    constexpr int SUBS = (MODE == 2) ? 8 : 16;
    const int uidx = blockIdx.x / SUBS, sub = blockIdx.x % SUBS;
    const Unit u = (MODE == 1) ? unit_dft(uidx) : unit_std(uidx, nN, g.lda, g.ldb);
    const int w = threadIdx.x >> 6, l = threadIdx.x & 63, wm = w >> 1, wn = w & 1, lr16 = l & 15, q = l >> 4;
    const int sm = (MODE == 2) ? (sub >> 1) : (sub >> 2), sn = (MODE == 2) ? (sub & 1) : (sub & 3);
    const char* Ab = (const char*)g.A + u.ao; const char* Bb = (const char*)g.Bt + u.bo;
    f32x4 acc[2][2] = {}, acc3[2][2] = {};
    for (int k0 = 0; k0 < g.K; k0 += 32) {
        bf16x8 a[2], b[2], b3[2];
#pragma unroll
        for (int i = 0; i < 2; ++i) a[i] = *(const bf16x8*)(Ab + ((size_t)(sm * 64 + wm * 32 + i * 16 + lr16) * g.lda + k0 + 8 * q) * 2);
#pragma unroll
        for (int j = 0; j < 2; ++j) {
            const int br = sn * 64 + wn * 32 + j * 16 + lr16;
            b[j] = *(const bf16x8*)(Bb + ((size_t)br * g.ldb + k0 + 8 * q) * 2);
            if (MODE == 2) b3[j] = *(const bf16x8*)(Bb + ((size_t)(br + 128) * g.ldb + k0 + 8 * q) * 2);
        }
#pragma unroll
        for (int i = 0; i < 2; ++i)
#pragma unroll
            for (int j = 0; j < 2; ++j) {
                acc[i][j] = __builtin_amdgcn_mfma_f32_16x16x32_bf16(a[i], b[j], acc[i][j], 0, 0, 0);
                if (MODE == 2) acc3[i][j] = __builtin_amdgcn_mfma_f32_16x16x32_bf16(a[i], b3[j], acc3[i][j], 0, 0, 0);
            }
    }
#pragma unroll
    for (int i = 0; i < 2; ++i)
#pragma unroll
        for (int j = 0; j < 2; ++j)
#pragma unroll
            for (int r = 0; r < 4; ++r) {
                const int lrow = sm * 64 + wm * 32 + i * 16 + q * 4 + r, lcol = sn * 64 + wn * 32 + j * 16 + lr16;
                if constexpr (MODE == 2) E.elem2(u, lrow, lcol, acc[i][j][r], acc3[i][j][r]); else E.elem(u, lrow, lcol, acc[i][j][r]);
            }
}

template <bool BF> __global__ __launch_bounds__(256) void naive_ssq(const void* X, int ld, int c0, float* ssqp) {
    const int row = blockIdx.x * 4 + (threadIdx.x >> 6), lane = threadIdx.x & 63; float s = 0.f;
    for (int c = lane; c < 1024; c += 64) { float v; if (BF) v = bf2f(((const bf16*)X)[(size_t)row * ld + c0 + c]); else v = ((const float*)X)[(size_t)row * ld + c0 + c]; s += v * v; }
    s = wave_sum(s);
    if (lane < 16) ssqp[(size_t)row * 16 + lane] = lane == 0 ? s : 0.f;
}

__global__ __launch_bounds__(256) void naive_attn(const bf16* QKV, bf16* Mix, const float* rel_table, const float* lambdas, const float* subln_g) {
    __shared__ float s0[SEQ], s1[SEQ]; __shared__ float qv[128]; __shared__ float red[8]; __shared__ float tb[257]; __shared__ float part[256];
    const int tid = threadIdx.x, lane = tid & 63, w = tid >> 6;
    const int qpos = blockIdx.x % SEQ, h = (blockIdx.x / SEQ) % 4, b = blockIdx.x / (SEQ * 4);
    const size_t rowq = (size_t)b * SEQ + qpos;
    if (tid < 128) qv[tid] = bf2f(QKV[rowq * NQKV + h * 128 + tid]);
    for (int i = tid; i < 257; i += 256) tb[i] = rel_table[t5_bucket(i - 128) * 4 + h] * LOG2E;
    float lp = (tid < 64) ? lambdas[tid] * lambdas[64 + tid] : (tid < 128 ? 0.f : (tid < 192 ? lambdas[128 + tid - 128] * lambdas[192 + tid - 128] : 0.f));
    lp = wave_sum(lp); if (lane == 0) red[w] = lp;
    __syncthreads();
    const float lam = expf(red[0]) - expf(red[2]) + LAM_INIT0;
    __syncthreads();
    float m0 = -1e30f, m1 = -1e30f;
    for (int kk = tid; kk < SEQ; kk += 256) {
        const bf16* kr = QKV + ((size_t)b * SEQ + kk) * NQKV + 512 + h * 128;
        float a0 = 0.f, a1 = 0.f;
        for (int d = 0; d < 64; ++d) { a0 += qv[d] * bf2f(kr[d]); a1 += qv[64 + d] * bf2f(kr[64 + d]); }
        int idx = kk - qpos + 128; idx = idx < 0 ? 0 : (idx > 256 ? 256 : idx);
        a0 += tb[idx]; a1 += tb[idx];
        s0[kk] = a0; s1[kk] = a1; m0 = fmaxf(m0, a0); m1 = fmaxf(m1, a1);
    }
#pragma unroll
    for (int o = 1; o < 64; o <<= 1) { m0 = fmaxf(m0, __shfl_xor(m0, o)); m1 = fmaxf(m1, __shfl_xor(m1, o)); }
    __syncthreads();
    if (lane == 0) { red[w] = m0; red[4 + w] = m1; }
    __syncthreads();
    m0 = fmaxf(fmaxf(red[0], red[1]), fmaxf(red[2], red[3])); m1 = fmaxf(fmaxf(red[4], red[5]), fmaxf(red[6], red[7]));
    __syncthreads();
    float l0 = 0.f, l1 = 0.f;
    for (int kk = tid; kk < SEQ; kk += 256) { const float p0 = exp2f(s0[kk] - m0), p1 = exp2f(s1[kk] - m1); s0[kk] = p0; s1[kk] = p1; l0 += p0; l1 += p1; }
    l0 = wave_sum(l0); l1 = wave_sum(l1);
    if (lane == 0) { red[w] = l0; red[4 + w] = l1; }
    __syncthreads();
    l0 = (red[0] + red[1]) + (red[2] + red[3]); l1 = (red[4] + red[5]) + (red[6] + red[7]);
    const float i0 = 1.0f / l0, i1 = lam / l1;
    for (int kk = tid; kk < SEQ; kk += 256) s0[kk] = s0[kk] * i0 - s1[kk] * i1;
    __syncthreads();
    const int e = tid & 127, half = tid >> 7; float o = 0.f;
    for (int kk = half * (SEQ / 2); kk < (half + 1) * (SEQ / 2); ++kk) o += s0[kk] * bf2f(QKV[((size_t)b * SEQ + kk) * NQKV + 1024 + h * 128 + e]);
    part[tid] = o;
    __syncthreads();
    if (tid < 128) {
        o = part[tid] + part[tid + 128];
        float sq = wave_sum(o * o);
        if (lane == 0) red[w] = sq;
    }
    __syncthreads();
    if (tid < 128) {
        const float r = 1.0f / sqrtf((red[0] + red[1]) * (1.0f / 128.0f) + RMS_EPS);
        Mix[rowq * NMIX + 1024 + h * 128 + e] = (bf16)f2bf(o * r * subln_g[e] * (1.0f - LAM_INIT0));
    }
}

__global__ __launch_bounds__(128) void naive_sgu(const bf16* UV, const bf16* Wsb, const float* b_s, const float* v_norm_g, const float* ssqv, bf16* Y) {
    const int p = blockIdx.x & 127, g = (blockIdx.x >> 7) & 7, ch = blockIdx.x >> 10, c = threadIdx.x;
    const int col = g * 128 + c; const float gv = v_norm_g[col];
    float acc = 0.f;
    for (int q = 0; q < 128; ++q) {
        const int row = ch * 128 + q;
        const float vn = bf2f((bf16)f2bf(bf2f(UV[(size_t)row * NUV + 1024 + col]) * rstd_from(ssqv, row) * gv));
        acc += bf2f(Wsb[(g * 128 + p) * 128 + q]) * vn;
    }
    const int row = ch * 128 + p;
    const float sv = acc + b_s[g * 128 + p];
    Y[(size_t)row * D + col] = (bf16)f2bf(bf2f(UV[(size_t)row * NUV + col]) * sv);
}

__global__ __launch_bounds__(256) void final_norm(float* out, const float* ssqp, const float* g) {
    const int row = blockIdx.x * 4 + (threadIdx.x >> 6), lane = threadIdx.x & 63;
    const float r = rstd_from(ssqp, row);
    f32x4* o = (f32x4*)(out + (size_t)row * D) + lane; const f32x4* gg = (const f32x4*)g + lane;
#pragma unroll
    for (int j = 0; j < 4; ++j) { f32x4 v = o[64 * j]; const f32x4 gv = gg[64 * j]; v = v * r * gv; o[64 * j] = v; }
}

struct ProArgs { const float* in[17]; unsigned char* ws; float* out; };
__device__ __forceinline__ void tr_item(const float* W, int ldsrc, int k0, int n0, bf16* WT, int lddst, int rowbase, int kdst0, const float* gs, LAS float* scr, int lane) {
#pragma unroll 8
    for (int i = 0; i < 32; ++i) { const int kk = 2 * i + (lane >> 5); float v = W[(size_t)(k0 + kk) * ldsrc + n0 + (lane & 31)]; if (gs) v *= gs[k0 + kk]; scr[kk * 33 + (lane & 31)] = v; }
    asm volatile("s_waitcnt lgkmcnt(0)" ::: "memory");
    const int c = lane & 7;
#pragma unroll
    for (int j = 0; j < 4; ++j) { const int n = (lane >> 3) + 8 * j; const LAS float* s = scr + (8 * c) * 33 + n;
        v4u o; o.x = pk2(s[0 * 33], s[1 * 33]); o.y = pk2(s[2 * 33], s[3 * 33]); o.z = pk2(s[4 * 33], s[5 * 33]); o.w = pk2(s[6 * 33], s[7 * 33]);
        *(v4u*)(WT + (size_t)(rowbase + n) * lddst + kdst0 + 8 * c) = o; }
    asm volatile("s_waitcnt lgkmcnt(0)" ::: "memory");
}
__device__ __forceinline__ void prologue_body(const ProArgs& P, LAS unsigned char* lds, int gw, int NGW, int lane, int gtid, int NGT) {
    LAS float* scr = (LAS float*)(lds + (threadIdx.x >> 6) * 16384);
    LAS float* tab = (LAS float*)(lds + 131072 + 1024 + (threadIdx.x >> 6) * 512);
    unsigned char* ws = P.ws;
    const float* x = P.in[0]; const float* g_mix = P.in[2]; const float* g_ffn = P.in[3];
    const float* w_in = P.in[4]; const float* w_out0 = P.in[5]; const float* w_uv = P.in[8]; const float* w_s = P.in[10]; const float* w_out1 = P.in[12];
    const float* w1 = P.in[13]; const float* w3 = P.in[14]; const float* w2 = P.in[15];
    bf16* Wqkv = (bf16*)(ws + WS_WQKV); bf16* Wf = (bf16*)(ws + WS_WF); bf16* Wo0 = (bf16*)(ws + WS_WO0); bf16* Wuv = (bf16*)(ws + WS_WUV); bf16* Wo1 = (bf16*)(ws + WS_WO1);
    constexpr int I_FOLD = 2 * 4 * 32 * 4;
    constexpr int I_WIN = 16 * 64;
    constexpr int I_WO0 = 8 * 32;
    constexpr int I_WUV = 16 * 64, I_WO1 = 16 * 32;
    constexpr int I_W1 = 16 * 88, I_W2 = 44 * 32;
    constexpr int NITEMS = I_FOLD + I_WIN + I_WO0 + I_WUV + I_WO1 + 4 * I_W1 + 2 * I_W2;
    for (int it = gw; it < NITEMS; it += NGW) {
        int r = it;
        if (r < I_FOLD) {
            const int cq = r & 3, nb = (r >> 2) & 31, g = (r >> 7) & 3, part = r >> 9;
            for (int i = lane; i < 128 * 32; i += 64) scr[i] = w_out0[(size_t)(g * 128 + (i >> 5)) * D + nb * 32 + (i & 31)];
            for (int i = lane; i < 128; i += 64) tab[i] = part ? -__builtin_amdgcn_sinf((float)i * (1.0f / 128.0f)) : __builtin_amdgcn_cosf((float)i * (1.0f / 128.0f));
            asm volatile("s_waitcnt lgkmcnt(0)" ::: "memory");
            const int n = lane & 31, chalf = lane >> 5; float o[16];
#pragma unroll
            for (int ci = 0; ci < 16; ++ci) { const int c = cq * 32 + chalf * 16 + ci; float s = 0.f;
                for (int l = 0; l < 128; ++l) s += tab[(l * c) & 127] * scr[l * 32 + n];
                o[ci] = s * DFT_SCALE; }
            v4u o0, o1; o0.x = pk2(o[0], o[1]); o0.y = pk2(o[2], o[3]); o0.z = pk2(o[4], o[5]); o0.w = pk2(o[6], o[7]); o1.x = pk2(o[8], o[9]); o1.y = pk2(o[10], o[11]); o1.z = pk2(o[12], o[13]); o1.w = pk2(o[14], o[15]);
            bf16* dst = Wo0 + (size_t)(nb * 32 + n) * NMIX + part * 512 + g * 128 + cq * 32 + chalf * 16;
            *(v4u*)dst = o0; *(v4u*)(dst + 8) = o1;
            asm volatile("s_waitcnt lgkmcnt(0)" ::: "memory");
            continue; }
        r -= I_FOLD;
        const float* src; int ldsrc, k0, n0, lddst, rowbase, kdst0; bf16* dst; const float* gs = nullptr;
        if (r < I_WIN) { const int kb = r / 64, nb = r % 64; n0 = nb * 32; src = w_in; ldsrc = 2048; k0 = kb * 64; lddst = D; kdst0 = k0; gs = g_mix;
            if (n0 < 512) { dst = Wf; rowbase = n0; } else { dst = Wqkv; rowbase = n0 - 512; } }
        else if ((r -= I_WIN) < I_WO0) { const int kb = r / 32, nb = r % 32; src = w_out0; ldsrc = D; k0 = 512 + kb * 64; n0 = nb * 32; dst = Wo0; lddst = NMIX; rowbase = n0; kdst0 = 1024 + kb * 64; }
        else if ((r -= I_WO0) < I_WUV) { const int kb = r / 64, nb = r % 64; src = w_uv; ldsrc = 2048; k0 = kb * 64; n0 = nb * 32; dst = Wuv; lddst = D; rowbase = n0; kdst0 = k0; gs = g_mix + D; }
        else if ((r -= I_WUV) < I_WO1) { const int kb = r / 32, nb = r % 32; src = w_out1; ldsrc = D; k0 = kb * 64; n0 = nb * 32; dst = Wo1; lddst = D; rowbase = n0; kdst0 = k0; }
        else if ((r -= I_WO1) < 4 * I_W1) { const int which = r / I_W1, rr = r % I_W1, L = which >> 1, is3 = which & 1; const int kb = rr / 88, nb = rr % 88; n0 = nb * 32;
            src = (is3 ? w3 : w1) + (size_t)L * D * FF; ldsrc = FF; k0 = kb * 64; dst = (bf16*)(ws + WS_W13 + (size_t)L * 11 * MiB); lddst = D; rowbase = (n0 / 128) * 256 + is3 * 128 + (n0 % 128); kdst0 = k0; gs = g_ffn + L * D; }
        else { r -= 4 * I_W1; const int L = r / I_W2, rr = r % I_W2; const int kb = rr / 32, nb = rr % 32;
            src = w2 + (size_t)L * FF * D; ldsrc = D; k0 = kb * 64; n0 = nb * 32; dst = (bf16*)(ws + WS_W2 + (size_t)L * (11 * MiB / 2)); lddst = FF; rowbase = n0; kdst0 = k0; }
        tr_item(src, ldsrc, k0, n0, dst, lddst, rowbase, kdst0, gs, scr, lane);
    }
    bf16* XB = (bf16*)(ws + WS_XB); float* rstd0 = (float*)(ws + WS_RSTD0);
    for (int m = gw; m < M; m += NGW) {
        const f32x4* xr = (const f32x4*)(x + (size_t)m * D) + lane; f32x4 v[4]; float s = 0.f;
#pragma unroll
        for (int j = 0; j < 4; ++j) { v[j] = xr[64 * j]; s += (v[j].x * v[j].x + v[j].y * v[j].y) + (v[j].z * v[j].z + v[j].w * v[j].w); }
        s = wave_sum(s);
        unsigned long long* o8 = (unsigned long long*)(XB + (size_t)m * D) + lane;
#pragma unroll
        for (int j = 0; j < 4; ++j) o8[64 * j] = (unsigned long long)pk2(v[j].x, v[j].y) | ((unsigned long long)pk2(v[j].z, v[j].w) << 32);
        if (lane == 0) rstd0[m] = 1.0f / sqrtf(s * (1.0f / 1024.0f) + RMS_EPS);
    }
    bf16* Dm = (bf16*)(ws + WS_R2);
    for (int i = gtid; i < 8192 * 512; i += NGT) {
        const int r = i >> 9, s0 = (i & 511) * 8, rr = r & 4095; float v[8];
#pragma unroll
        for (int j = 0; j < 8; ++j) { const float ph = (float)((rr * (s0 + j)) & 4095) * (1.0f / 4096.0f); v[j] = r < 4096 ? __builtin_amdgcn_cosf(ph) : __builtin_amdgcn_sinf(ph); }
        v4u o; o.x = pk2(v[0], v[1]); o.y = pk2(v[2], v[3]); o.z = pk2(v[4], v[5]); o.w = pk2(v[6], v[7]);
        *(v4u*)(Dm + (size_t)r * 4096 + s0) = o;
    }
    bf16* Wsb = (bf16*)(ws + WS_WS);
    for (int i = gtid; i < 8 * 128 * 128 / 8; i += NGT) { const f32x4 a = ((const f32x4*)w_s)[2 * i], b = ((const f32x4*)w_s)[2 * i + 1];
        v4u o; o.x = pk2(a.x, a.y); o.y = pk2(a.z, a.w); o.z = pk2(b.x, b.y); o.w = pk2(b.z, b.w); ((v4u*)Wsb)[i] = o; }
}

namespace pg8 {
#define PG8_LAS __attribute__((address_space(3)))
typedef unsigned short bf16_t;
typedef unsigned u32x4 __attribute__((ext_vector_type(4)));
constexpr int BM = 256, BK = 64, HALF = 128, HTB = HALF * BK * 2  , STAGE_BYTES = 8 * HTB, NXCD = 8, WGM = 8;
__host__ __device__ __forceinline__ int lds_byte(int r, int c) { const int st = (r >> 4) * 2 + (c >> 5), rr = r & 15, cc = c & 31, ob = rr * 64 + cc * 2; return st * 1024 + (ob ^ (((ob >> 9) & 1) << 5)); }
__host__ __device__ __forceinline__ void stage_rc(int b, int& R, int& C) { const int st = b / 1024, sb = b % 1024, swz = sb ^ (((sb >> 9) & 1) << 5); R = (st >> 1) * 16 + swz / 64; C = (st & 1) * 32 + (swz % 64) / 2; }
__host__ __device__ __forceinline__ int perm32(int rho) { const int n = rho >> 4, i = rho & 15; return 8 * (i >> 2) + 4 * n + (i & 3); }

struct Order {
    int nM, nN, nwg, G, c, mode, lda, ldb;
    __device__ void init(int nM_, int nN_, int G_, int c_, int mode_, int lda_, int ldb_) { nM = nM_; nN = nN_; nwg = nM * nN; G = G_; c = c_; mode = mode_; lda = lda_; ldb = ldb_; }
    __device__ bool next(int i, Unit& u) const {
        const long L = (long)i * G + c; if (L >= nwg) return false;
        int wgid = (int)L; { const int q = nwg / NXCD, r = nwg % NXCD, xcd = wgid % NXCD, off = wgid / NXCD; wgid = (xcd < r ? xcd * (q + 1) : r * (q + 1) + (xcd - r) * q) + off; }
        const int nig = WGM * nN, gid = wgid / nig, fm = gid * WGM, gsz = (nM - fm) < WGM ? (nM - fm) : WGM;
        u.pm = fm + ((wgid % nig) % gsz); u.pn = (wgid % nig) / gsz;
        if (mode == 1) { u.ao = (long)u.pm * 256 * 4096 * 2; u.bo = ((long)(u.pn & 1) * 256 * M + (long)(u.pn >> 1) * SEQ) * 2; }
        else { u.ao = (long)u.pm * 256 * lda * 2; u.bo = (long)u.pn * 256 * ldb * 2; }
        return true;
    }
    __device__ __forceinline__ void a_ready(const Unit&) const {}
    __device__ __forceinline__ void done(const Unit&) const {}
};
template <class Epi, class Sched, bool ALIGN_EPI = false, bool SP2 = false>
__device__ __forceinline__ void gemm_phase(PG8_LAS unsigned char* lds, const GemmD g, const Sched& S, const Epi& E) {
    int tid_ = threadIdx.x; asm volatile("" : "+v"(tid_));
    const int tid = tid_, wid = __builtin_amdgcn_readfirstlane(tid >> 6), lane = tid & 63, wr = wid >> 2, wc = wid & 3, fr = lane & 15, fq = lane >> 4;
    const int K = g.K, nt = K / BK;
    unsigned voffA[2], voffB[2];
#pragma unroll
    for (int i = 0; i < 2; ++i) { int R, C; stage_rc(tid * 16 + i * 8192, R, C); const int Rb = Epi::PERM ? ((R & ~31) + perm32(R & 31)) : R;
        voffA[i] = (unsigned)(R * g.lda + C) * 2u; voffB[i] = (unsigned)(Rb * g.ldb + C) * 2u; }
    const size_t kstep = (size_t)(BK * 2);
    const size_t hstepA = (size_t)HALF * g.lda * 2, hstepB = (size_t)HALF * g.ldb * 2;
    const unsigned ldsw = (unsigned)wid * 1024u;
    const int aoff = lds_byte(wr * 64 + fr, fq * 8), boff = lds_byte(wc * 32 + fr, fq * 8);
#define PG8_SA(b, h) (((b) * 2 + (h)) * HTB)
#define PG8_SB(b, h) ((4 + (b) * 2 + (h)) * HTB)
#define PG8_STAGE(bufoff, gbase, voff) do { _Pragma("unroll") for (int _i = 0; _i < 2; ++_i) \
        __builtin_amdgcn_global_load_lds((const unsigned*)((const char*)(gbase) + (voff)[_i]), (PG8_LAS unsigned*)(lds + (bufoff) + ldsw + _i * 8192), 16, 0, 0); } while (0)
#define PG8_LDA(dst, b, h) do { _Pragma("unroll") for (int m = 0; m < 4; ++m) _Pragma("unroll") for (int k = 0; k < 2; ++k) dst[m][k] = *(const PG8_LAS bf16x8*)(lds + PG8_SA(b, h) + aoff + m * 2048 + k * 1024); } while (0)
#define PG8_LDB(dst, b, h) do { _Pragma("unroll") for (int n = 0; n < 2; ++n) _Pragma("unroll") for (int k = 0; k < 2; ++k) dst[n][k] = *(const PG8_LAS bf16x8*)(lds + PG8_SB(b, h) + boff + n * 2048 + k * 1024); } while (0)
#define PG8_MMA(ai, bj, At, Bt) do { __builtin_amdgcn_s_setprio(1); _Pragma("unroll") for (int m = 0; m < 4; ++m) _Pragma("unroll") for (int n = 0; n < 2; ++n) _Pragma("unroll") for (int k = 0; k < 2; ++k) \
        acc[ai][bj][m][n] = __builtin_amdgcn_mfma_f32_16x16x32_bf16(Bt[n][k], At[m][k], acc[ai][bj][m][n], 0, 0, 0); __builtin_amdgcn_s_setprio(0); } while (0)
#define PG8_WAIT_V(n) asm volatile("s_waitcnt vmcnt(" #n ")" ::: "memory")
#define PG8_WAIT_L(n) asm volatile("s_waitcnt lgkmcnt(" #n ")" ::: "memory")
#define PG8_BAR __builtin_amdgcn_s_barrier()
#define PG8_SCHED __builtin_amdgcn_sched_barrier(0)
    Unit cur, nxt; int ui = 0;
    if (!S.next(0, cur)) return;
    f32x4 acc[2][2][4][2];
#pragma unroll
    for (int a = 0; a < 2; ++a)
#pragma unroll
        for (int b = 0; b < 2; ++b)
#pragma unroll
            for (int m = 0; m < 4; ++m)
#pragma unroll
                for (int n = 0; n < 2; ++n) acc[a][b][m][n] = (f32x4){0.f, 0.f, 0.f, 0.f};
    bf16x8 At[4][2], B0[2][2], B1[2][2];
    const char* cA = (const char*)g.A + cur.ao; const char* cB = (const char*)g.Bt + cur.bo;
    S.a_ready(cur);
    if constexpr (SP2) {
        PG8_STAGE(PG8_SB(0, 0), cB, voffB); PG8_STAGE(PG8_SB(0, 1), cB + hstepB, voffB); PG8_STAGE(PG8_SA(0, 0), cA, voffA); PG8_STAGE(PG8_SA(0, 1), cA + hstepA, voffA);
        if (wr == 1) PG8_BAR;
        PG8_WAIT_V(2); PG8_BAR;
        PG8_STAGE(PG8_SB(1, 0), cB + kstep, voffB); PG8_STAGE(PG8_SA(1, 0), cA + kstep, voffA); PG8_STAGE(PG8_SB(1, 1), cB + hstepB + kstep, voffB);
        PG8_WAIT_V(6); PG8_BAR;
    } else {
        PG8_STAGE(PG8_SB(0, 0), cB, voffB); PG8_STAGE(PG8_SA(0, 0), cA, voffA); PG8_STAGE(PG8_SB(0, 1), cB + hstepB, voffB); PG8_STAGE(PG8_SA(0, 1), cA + hstepA, voffA);
        if (wr == 1) PG8_BAR;
        PG8_WAIT_V(4); PG8_BAR;
        PG8_STAGE(PG8_SB(1, 0), cB + kstep, voffB); PG8_STAGE(PG8_SA(1, 0), cA + kstep, voffA); PG8_STAGE(PG8_SB(1, 1), cB + hstepB + kstep, voffB);
        PG8_WAIT_V(6); PG8_BAR;
    }
    for (;;) {
        const bool has_next = S.next(ui + 1, nxt);
        const char* nA = has_next ? (const char*)g.A + nxt.ao : cA; const char* nB = has_next ? (const char*)g.Bt + nxt.bo : cB;
        for (int t = 0; t < nt; t += 2) {
            const bool last = (t == nt - 2);
            const char* a1 = cA + (size_t)(t + 1) * kstep;
            const char* a2 = last ? nA : cA + (size_t)(t + 2) * kstep; const char* b2 = last ? nB : cB + (size_t)(t + 2) * kstep;
            const char* a3 = a2 + kstep; const char* b3 = b2 + kstep;
            if (last && has_next) S.a_ready(nxt);
            if constexpr (SP2) {
            PG8_LDB(B0, 0, 0); PG8_LDB(B1, 0, 1); PG8_SCHED; PG8_LDA(At, 0, 0); PG8_STAGE(PG8_SA(1, 1), a1 + hstepA, voffA);
            PG8_WAIT_V(8); PG8_WAIT_L(0); PG8_BAR; PG8_MMA(0, 0, At, B0); PG8_MMA(0, 1, At, B1); PG8_BAR; PG8_SCHED;
            PG8_LDA(At, 0, 1); PG8_STAGE(PG8_SB(0, 0), b2, voffB); PG8_STAGE(PG8_SB(0, 1), b2 + hstepB, voffB); PG8_STAGE(PG8_SA(0, 0), a2, voffA);
            PG8_WAIT_V(8); PG8_WAIT_L(0); PG8_BAR; PG8_MMA(1, 0, At, B0); PG8_MMA(1, 1, At, B1); PG8_BAR; PG8_SCHED;
            PG8_LDB(B0, 1, 0); PG8_LDB(B1, 1, 1); PG8_SCHED; PG8_LDA(At, 1, 0); PG8_STAGE(PG8_SA(0, 1), a2 + hstepA, voffA);
            PG8_WAIT_V(8); PG8_WAIT_L(0); PG8_BAR; PG8_MMA(0, 0, At, B0); PG8_MMA(0, 1, At, B1); PG8_BAR; PG8_SCHED;
            PG8_LDA(At, 1, 1); PG8_STAGE(PG8_SB(1, 0), b3, voffB); PG8_STAGE(PG8_SB(1, 1), b3 + hstepB, voffB); PG8_STAGE(PG8_SA(1, 0), a3, voffA);
            PG8_WAIT_V(8); PG8_WAIT_L(0); PG8_BAR; PG8_MMA(1, 0, At, B0); PG8_MMA(1, 1, At, B1); PG8_BAR; PG8_SCHED;
            } else {
            PG8_LDB(B0, 0, 0); PG8_SCHED; PG8_LDA(At, 0, 0); PG8_STAGE(PG8_SA(1, 1), a1 + hstepA, voffA);
            PG8_WAIT_L(8); PG8_BAR; PG8_WAIT_L(0); PG8_MMA(0, 0, At, B0); PG8_BAR; PG8_SCHED;
            PG8_LDB(B1, 0, 1); PG8_STAGE(PG8_SB(0, 0), b2, voffB);
            PG8_BAR; PG8_WAIT_L(0); PG8_MMA(0, 1, At, B1); PG8_BAR;
            PG8_LDA(At, 0, 1); PG8_STAGE(PG8_SA(0, 0), a2, voffA);
            PG8_BAR; PG8_WAIT_L(0); PG8_MMA(1, 0, At, B0); PG8_BAR; PG8_SCHED;
            PG8_STAGE(PG8_SB(0, 1), b2 + hstepB, voffB);
            PG8_WAIT_V(6); PG8_BAR; PG8_MMA(1, 1, At, B1); PG8_BAR;
            PG8_LDB(B0, 1, 0); PG8_SCHED; PG8_LDA(At, 1, 0); PG8_STAGE(PG8_SA(0, 1), a2 + hstepA, voffA);
            PG8_WAIT_L(8); PG8_BAR; PG8_WAIT_L(0); PG8_MMA(0, 0, At, B0); PG8_BAR; PG8_SCHED;
            PG8_LDB(B1, 1, 1); PG8_STAGE(PG8_SB(1, 0), b3, voffB);
            PG8_BAR; PG8_WAIT_L(0); PG8_MMA(0, 1, At, B1); PG8_BAR;
            PG8_LDA(At, 1, 1); PG8_STAGE(PG8_SA(1, 0), a3, voffA);
            PG8_BAR; PG8_WAIT_L(0); PG8_MMA(1, 0, At, B0); PG8_BAR; PG8_SCHED;
            PG8_STAGE(PG8_SB(1, 1), b3 + hstepB, voffB);
            PG8_WAIT_V(6); PG8_BAR; PG8_MMA(1, 1, At, B1); PG8_BAR;
            }
        }
        if constexpr (ALIGN_EPI) { if (wr == 0) PG8_BAR; }
        if constexpr (!Epi::AFTER_DRAIN) { E(acc, cur, wr, wc, fr, fq); S.done(cur); }
        if (!has_next) break;
#pragma unroll
        for (int a = 0; a < 2; ++a)
#pragma unroll
            for (int b = 0; b < 2; ++b)
#pragma unroll
                for (int m = 0; m < 4; ++m)
#pragma unroll
                    for (int n = 0; n < 2; ++n) acc[a][b][m][n] = (f32x4){0.f, 0.f, 0.f, 0.f};
        cur = nxt; cA = nA; cB = nB; ++ui;
        if constexpr (ALIGN_EPI) { if (wr == 1) PG8_BAR; }
    }
    PG8_WAIT_V(0);
    if constexpr (!ALIGN_EPI) { if (wr == 0) PG8_BAR; }
    PG8_BAR;
    if constexpr (Epi::AFTER_DRAIN) { E.fused(acc, cur, wr, wc, fr, fq, lds, wid, lane); S.done(cur); }
#undef PG8_SA
#undef PG8_SB
#undef PG8_STAGE
#undef PG8_LDA
#undef PG8_LDB
#undef PG8_MMA
#undef PG8_WAIT_V
#undef PG8_WAIT_L
#undef PG8_BAR
#undef PG8_SCHED
}
}

namespace att {
using s16x4 = __attribute__((ext_vector_type(4))) short;
using f32x16 = __attribute__((ext_vector_type(16))) float;
constexpr int NW = 8, QBLK = 32, KVBLK = 64;
constexpr int SHM_K = KVBLK * 64 * 2, SHM_V = KVBLK * 128 * 2;
constexpr int OFF_V = 0, OFF_K = 3 * SHM_V, OFF_WS = OFF_K + 2 * SHM_K, OFF_TB = OFF_WS + NW * 64 * 4, ATT_LDS = OFF_TB + 448 * 4;
constexpr float THR = 8.0f;
#define SBAR() __builtin_amdgcn_sched_barrier(0)
#define KSWZ64(row, ch) ((row) * 128 + ((((ch) ^ ((row) >> 1)) & 7) << 4))
__device__ __forceinline__ int crow(int r, int hi) { return (r & 3) + 8 * (r >> 2) + 4 * hi; }
__device__ __forceinline__ unsigned cvtpk(float lo, float hi) { unsigned r; asm volatile("v_cvt_pk_bf16_f32 %0, %1, %2" : "=v"(r) : "v"(lo), "v"(hi)); return r; }
__device__ __forceinline__ void partialSM(f32x16& p0, f32x16& p1, float& m_reg, float& alpha) {
    float pmax = p0[0];
#pragma unroll
    for (int r = 1; r < 16; ++r) pmax = fmaxf(pmax, p0[r]);
#pragma unroll
    for (int r = 0; r < 16; ++r) pmax = fmaxf(pmax, p1[r]);
    { auto rr = __builtin_amdgcn_permlane32_swap(__float_as_uint(pmax), __float_as_uint(pmax), false, false); pmax = fmaxf(__uint_as_float(rr[0]), __uint_as_float(rr[1])); }
    float mn;
    if (__builtin_expect(__all(pmax - m_reg <= THR), 1)) { mn = m_reg; alpha = 1.f; }
    else { mn = fmaxf(m_reg, pmax); alpha = __builtin_amdgcn_exp2f(m_reg - mn); m_reg = mn; }
#pragma unroll
    for (int r = 0; r < 16; ++r) { p0[r] -= mn; p1[r] -= mn; }
#pragma unroll
    for (int r = 0; r < 16; ++r) p0[r] = __builtin_amdgcn_exp2f(p0[r]);
}
__device__ __forceinline__ void finishSM(f32x16& p0, f32x16& p1, float alpha, float& l_reg, bf16x8& pa0, bf16x8& pa1, bf16x8& pa2, bf16x8& pa3) {
#pragma unroll
    for (int r = 0; r < 16; ++r) p1[r] = __builtin_amdgcn_exp2f(p1[r]);
    float ps = 0;
#pragma unroll
    for (int r = 0; r < 16; ++r) ps += p0[r];
#pragma unroll
    for (int r = 0; r < 16; ++r) ps += p1[r];
    { auto rr = __builtin_amdgcn_permlane32_swap(__float_as_uint(ps), __float_as_uint(ps), false, false); ps = __uint_as_float(rr[0]) + __uint_as_float(rr[1]); }
    l_reg = l_reg * alpha + ps;
#define PK4(P, BASE, OUT) do { unsigned a0 = cvtpk(P[BASE + 0], P[BASE + 1]), a1 = cvtpk(P[BASE + 2], P[BASE + 3]);   \
    unsigned b0 = cvtpk(P[BASE + 4], P[BASE + 5]), b1 = cvtpk(P[BASE + 6], P[BASE + 7]);                              \
    auto r0 = __builtin_amdgcn_permlane32_swap(a0, b0, false, false); auto r1 = __builtin_amdgcn_permlane32_swap(a1, b1, false, false); \
    v4u w = {r0[0], r1[0], r0[1], r1[1]}; OUT = *reinterpret_cast<bf16x8*>(&w); } while (0)
    PK4(p0, 0, pa0); PK4(p0, 8, pa1); PK4(p1, 0, pa2); PK4(p1, 8, pa3);
#undef PK4
}
constexpr int TB_N = 448, TB_Z = 224;
__device__ __forceinline__ void bias_init(f32x16& p0, f32x16& p1, const float* tb, int k0, int qpos, int qw0, int hi) {
    const int relmax = k0 + 63 - qw0, relmin = k0 - (qw0 + 31);
    if (relmax <= -128) { const float c = tb[0];
#pragma unroll
        for (int r = 0; r < 16; ++r) { p0[r] = c; p1[r] = c; } }
    else if (relmin >= 128) { const float c = tb[TB_N - 1];
#pragma unroll
        for (int r = 0; r < 16; ++r) { p0[r] = c; p1[r] = c; } }
    else { const float* tp = tb + (k0 - qpos + TB_Z + 4 * hi);
#pragma unroll
        for (int r = 0; r < 16; ++r) { p0[r] = tp[(r & 3) + 8 * (r >> 2)]; p1[r] = tp[32 + (r & 3) + 8 * (r >> 2)]; } }
}
__device__ __forceinline__ void qkt(f32x16& p0, f32x16& p1, const char* Ks, const bf16x8* qr, int r32, int hi) {
#pragma unroll
    for (int d0 = 0; d0 < 4; ++d0) { const int ch = d0 * 2 + hi;
        const bf16x8 b0 = *reinterpret_cast<const bf16x8*>(Ks + KSWZ64(r32, ch));
        const bf16x8 b1 = *reinterpret_cast<const bf16x8*>(Ks + KSWZ64(32 + r32, ch));
        p0 = __builtin_amdgcn_mfma_f32_32x32x16_bf16(b0, qr[d0], p0, 0, 0, 0);
        p1 = __builtin_amdgcn_mfma_f32_32x32x16_bf16(b1, qr[d0], p1, 0, 0, 0); }
}
__device__ __forceinline__ int v_st(int k, int c) { const int kk = (k & ~0xC) | ((k & 4) << 1) | ((k & 8) >> 1); return ((kk >> 3) * 4 + (c >> 5)) * 512 + ((kk & 7) * 32 + (c & 31)) * 2; }
__device__ __forceinline__ int v_rd_base(int lane) { return ((lane & 3) << 3) | (((lane >> 2) & 3) << 6) | (((lane >> 4) & 1) << 5) | (((lane >> 5) & 1) << 8); }
constexpr int v_rd_off(int d0, int ks, int half) { return d0 * 512 + ks * 4096 + half * 2048; }
template <int OFF> __device__ __forceinline__ s16x4 tr_read(int vb) { s16x4 r; asm volatile("ds_read_b64_tr_b16 %0, %1 offset:%2" : "=&v"(r) : "v"(vb), "i"(OFF) : "memory"); return r; }
template <int D0> __device__ __forceinline__ void pv_one(f32x16& od, int vb, bf16x8 pa0, bf16x8 pa1, bf16x8 pa2, bf16x8 pa3) {
    const s16x4 l0 = tr_read<v_rd_off(D0, 0, 0)>(vb), h0 = tr_read<v_rd_off(D0, 0, 1)>(vb), l1 = tr_read<v_rd_off(D0, 1, 0)>(vb), h1 = tr_read<v_rd_off(D0, 1, 1)>(vb);
    const s16x4 l2 = tr_read<v_rd_off(D0, 2, 0)>(vb), h2 = tr_read<v_rd_off(D0, 2, 1)>(vb), l3 = tr_read<v_rd_off(D0, 3, 0)>(vb), h3 = tr_read<v_rd_off(D0, 3, 1)>(vb);
    asm volatile("s_waitcnt lgkmcnt(0)" ::: "memory"); SBAR();
#define PK(L, H) (bf16x8){L[0], L[1], L[2], L[3], H[0], H[1], H[2], H[3]}
    od = __builtin_amdgcn_mfma_f32_32x32x16_bf16(pa0, PK(l0, h0), od, 0, 0, 0);
    od = __builtin_amdgcn_mfma_f32_32x32x16_bf16(pa1, PK(l1, h1), od, 0, 0, 0);
    od = __builtin_amdgcn_mfma_f32_32x32x16_bf16(pa2, PK(l2, h2), od, 0, 0, 0);
    od = __builtin_amdgcn_mfma_f32_32x32x16_bf16(pa3, PK(l3, h3), od, 0, 0, 0);
#undef PK
}
__device__ __forceinline__ void pv_d0(f32x16* o, int vb, bf16x8 pa0, bf16x8 pa1, bf16x8 pa2, bf16x8 pa3) {
    pv_one<0>(o[0], vb, pa0, pa1, pa2, pa3); pv_one<1>(o[1], vb, pa0, pa1, pa2, pa3); pv_one<2>(o[2], vb, pa0, pa1, pa2, pa3); pv_one<3>(o[3], vb, pa0, pa1, pa2, pa3);
}
__device__ __forceinline__ void glds16(const void* gsrc, unsigned lds_dst) { unsigned keep;
    asm volatile("s_mov_b32 %0, m0\n\ts_mov_b32 m0, %2\n\ts_nop 0\n\tglobal_load_lds_dwordx4 %1, off\n\ts_mov_b32 m0, %0" : "=&s"(keep) : "v"(gsrc), "s"(lds_dst) : "memory"); }
#define WAIT_BAR() asm volatile("s_waitcnt vmcnt(0) lgkmcnt(0)\n\ts_barrier" ::: "memory")
__device__ __forceinline__ void attn_unit(int b, int h, int qb, const bf16* __restrict__ QKV, float* Osc, bf16* Mix, const float* rel_table, const float* lambdas, const float* subln_g, char* lds) {
    int tid_ = threadIdx.x; asm volatile("" : "+v"(tid_));
    const int tid = tid_, wid = __builtin_amdgcn_readfirstlane(tid >> 6), lane = tid & 63, r32 = lane & 31, hi = lane >> 5;
    char* V_lds = lds + OFF_V; char* K_lds = lds + OFF_K;
    float* wsf = (float*)(lds + OFF_WS) + wid * 64; float* li_l = wsf; float* al_l = wsf + 32; float* tb = (float*)(lds + OFF_TB);
    const unsigned lds0 = (unsigned)(uintptr_t)lds;
    const long rowbase = (long)b * SEQ; const int q0 = qb * 256, qw0 = q0 + wid * QBLK, qpos = qw0 + r32;
    WAIT_BAR();
    for (int i = tid; i < TB_N; i += NW * 64) tb[i] = rel_table[t5_bucket(i - TB_Z) * 4 + h] * LOG2E;
    float lam;
    { float s01 = lambdas[lane] * lambdas[64 + lane], s23 = lambdas[128 + lane] * lambdas[192 + lane]; s01 = wave_sum(s01); s23 = wave_sum(s23); lam = __expf(s01) - __expf(s23) + LAM_INIT0; }
    const int krow = wid * 8 + (lane >> 3), kch = (lane & 7) ^ ((krow >> 1) & 7);
    const long ksrc_off = (long)krow * NQKV + kch * 8;
    long vsrc_off[2];
#pragma unroll
    for (int i = 0; i < 2; ++i) { const int sub = (2 * wid + i) * 2 + (lane >> 5), kk = (sub >> 2) * 8 + ((lane >> 2) & 7), c = (sub & 3) * 32 + (lane & 3) * 8;
        const int k = (kk & ~0xC) | ((kk & 4) << 1) | ((kk & 8) >> 1); vsrc_off[i] = (long)k * NQKV + c; }
    const unsigned kdst = lds0 + OFF_K + wid * 1024, vdst = lds0 + OFF_V + wid * 2048;
    const int vb0 = (int)(uintptr_t)V_lds + v_rd_base(lane);
#pragma unroll 1
    for (int j = 0; j < 2; ++j) {
        const bf16* Kh = QKV + rowbase * NQKV + 512 + h * 128 + j * 64; const bf16* Vh = QKV + rowbase * NQKV + 1024 + h * 128;
#define DMA_KV(t, kslot, vslot) do { glds16(Kh + (long)(t) * KVBLK * NQKV + ksrc_off, (unsigned)__builtin_amdgcn_readfirstlane(kdst + (kslot) * SHM_K)); \
    glds16(Vh + (long)(t) * KVBLK * NQKV + vsrc_off[0], (unsigned)__builtin_amdgcn_readfirstlane(vdst + (vslot))); \
    glds16(Vh + (long)(t) * KVBLK * NQKV + vsrc_off[1], (unsigned)__builtin_amdgcn_readfirstlane(vdst + (vslot) + 1024)); } while (0)
        float m_reg = -1e30f, l_reg = 0; f32x16 o[4] = {}; bf16x8 qr[4];
        WAIT_BAR();
        DMA_KV(0, 0, 0);
        { const bf16* Qw = QKV + (rowbase + qpos) * NQKV + h * 128 + j * 64 + hi * 8;
#pragma unroll
          for (int d0 = 0; d0 < 4; ++d0) qr[d0] = *reinterpret_cast<const bf16x8*>(Qw + d0 * 16); }
#define RESC(a) do { if (__any((a) < 1.f)) { if (hi == 0) al_l[r32] = (a); asm volatile("s_waitcnt lgkmcnt(0)" ::: "memory"); \
    _Pragma("unroll") for (int d = 0; d < 4; ++d) _Pragma("unroll") for (int r = 0; r < 16; ++r) o[d][r] *= al_l[crow(r, hi)]; } } while (0)
        f32x16 pA0, pA1, pB0, pB1; float alA, alB; bf16x8 pa0, pa1, pa2, pa3; constexpr int NT = SEQ / KVBLK;
        int v_prev = 0, v_cur = SHM_V, v_next = 2 * SHM_V;
#define ROT() do { const int t_ = v_prev; v_prev = v_cur; v_cur = v_next; v_next = t_; } while (0)
        WAIT_BAR();
        DMA_KV(1, 1, SHM_V);
        bias_init(pA0, pA1, tb, 0, qpos, qw0, hi); qkt(pA0, pA1, K_lds, qr, r32, hi); partialSM(pA0, pA1, m_reg, alA);
        WAIT_BAR();
#pragma unroll 1
        for (int jt = 1; jt + 1 < NT; jt += 2) {
            DMA_KV(jt + 1, 0, v_next);
            SBAR(); bias_init(pB0, pB1, tb, jt * KVBLK, qpos, qw0, hi); qkt(pB0, pB1, K_lds + SHM_K, qr, r32, hi);
            finishSM(pA0, pA1, alA, l_reg, pa0, pa1, pa2, pa3); SBAR();
            pv_d0(o, vb0 + v_prev, pa0, pa1, pa2, pa3); partialSM(pB0, pB1, m_reg, alB);
            RESC(alB); WAIT_BAR(); ROT();
            if (jt + 2 < NT) DMA_KV(jt + 2, 1, v_next);
            SBAR(); bias_init(pA0, pA1, tb, (jt + 1) * KVBLK, qpos, qw0, hi); qkt(pA0, pA1, K_lds, qr, r32, hi);
            finishSM(pB0, pB1, alB, l_reg, pa0, pa1, pa2, pa3); SBAR();
            pv_d0(o, vb0 + v_prev, pa0, pa1, pa2, pa3); partialSM(pA0, pA1, m_reg, alA);
            RESC(alA); WAIT_BAR(); ROT();
        }
        SBAR(); bias_init(pB0, pB1, tb, (NT - 1) * KVBLK, qpos, qw0, hi); qkt(pB0, pB1, K_lds + SHM_K, qr, r32, hi);
        finishSM(pA0, pA1, alA, l_reg, pa0, pa1, pa2, pa3); SBAR();
        pv_d0(o, vb0 + v_prev, pa0, pa1, pa2, pa3); partialSM(pB0, pB1, m_reg, alB);
        RESC(alB);
        finishSM(pB0, pB1, alB, l_reg, pa0, pa1, pa2, pa3); SBAR();
        pv_d0(o, vb0 + v_cur, pa0, pa1, pa2, pa3);
        if (hi == 0) li_l[r32] = l_reg; asm volatile("s_waitcnt lgkmcnt(0)" ::: "memory");
#pragma unroll
        for (int r = 0; r < 16; ++r) { const float rl = __builtin_amdgcn_rcpf(li_l[crow(r, hi)]);
#pragma unroll
            for (int d0 = 0; d0 < 4; ++d0) o[d0][r] *= rl; }
        int le = lane; asm volatile("" : "+v"(le));
        const int lofs = (le >> 5) * 4, lcol = le & 31;
        float* ob = Osc + (rowbase + qw0) * 512 + h * 128; bf16* mb = Mix + (rowbase + qw0) * NMIX + 1024 + h * 128;
        if (j == 0) {
#pragma unroll
            for (int r = 0; r < 16; ++r) { const int rr = lofs + (r & 3) + 8 * (r >> 2);
#pragma unroll
                for (int d0 = 0; d0 < 4; ++d0) ob[rr * 512 + d0 * 32 + lcol] = o[d0][r]; }
        } else {
#pragma unroll
            for (int r = 0; r < 16; ++r) { const int rr = lofs + (r & 3) + 8 * (r >> 2);
#pragma unroll
                for (int d0 = 0; d0 < 4; ++d0) o[d0][r] = ob[rr * 512 + d0 * 32 + lcol] - lam * o[d0][r];
                if ((r & 3) == 3) asm volatile("" ::: "memory"); }
            float gq[4];
#pragma unroll
            for (int d0 = 0; d0 < 4; ++d0) gq[d0] = subln_g[d0 * 32 + lcol] * (1.0f - LAM_INIT0);
#pragma unroll
            for (int r = 0; r < 16; ++r) { const int rr = lofs + (r & 3) + 8 * (r >> 2);
                float sq = (o[0][r] * o[0][r] + o[1][r] * o[1][r]) + (o[2][r] * o[2][r] + o[3][r] * o[3][r]);
#pragma unroll
                for (int of = 1; of < 32; of <<= 1) sq += __shfl_xor(sq, of);
                const float rs = 1.0f / sqrtf(sq * (1.0f / 128.0f) + RMS_EPS);
#pragma unroll
                for (int d0 = 0; d0 < 4; ++d0) mb[rr * NMIX + d0 * 32 + lcol] = (bf16)f2bf(o[d0][r] * rs * gq[d0]); }
        }
#undef DMA_KV
#undef RESC
#undef ROT
    }
    asm volatile("s_waitcnt vmcnt(0)" ::: "memory");
}
#undef WAIT_BAR
#undef SBAR
}

namespace sgu {
using f32x16 = __attribute__((ext_vector_type(16))) float;
constexpr int PITCH = 272;
constexpr int OFF_W = 0, OFF_V = 128 * PITCH, SGU_LDS = 2 * 128 * PITCH;
__device__ __forceinline__ void sgu_unit(int ch, int g, const bf16* UV, const bf16* Wsb, const float* b_s, const float* v_norm_g, const float* ssqv, bf16* Y, char* lds) {
    int tid_ = threadIdx.x; asm volatile("" : "+v"(tid_));
    const int tid = tid_, wid = __builtin_amdgcn_readfirstlane(tid >> 6), lane = tid & 63, r32 = lane & 31, hi = lane >> 5;
    __syncthreads();
#pragma unroll
    for (int jj = 0; jj < 4; ++jj) { const int i = tid + 512 * jj, rr = i >> 4, c8 = (i & 15) * 8;
        *(v4u*)(lds + OFF_W + rr * PITCH + c8 * 2) = *(const v4u*)(Wsb + ((size_t)g * 128 + rr) * 128 + c8);
        const int row = ch * 128 + rr; const float rs = rstd_from(ssqv, row);
        const v4u raw = *(const v4u*)(UV + (size_t)row * NUV + 1024 + g * 128 + c8);
        const f32x4 g0 = *(const f32x4*)(v_norm_g + g * 128 + c8), g1 = *(const f32x4*)(v_norm_g + g * 128 + c8 + 4);
        const unsigned w[4] = {raw.x, raw.y, raw.z, raw.w}; const float gg[8] = {g0.x, g0.y, g0.z, g0.w, g1.x, g1.y, g1.z, g1.w};
#pragma unroll
        for (int e = 0; e < 8; ++e) { const float v = __builtin_bit_cast(float, (e & 1) ? (w[e >> 1] & 0xffff0000u) : (w[e >> 1] << 16));
            *(bf16*)(lds + OFF_V + (c8 + e) * PITCH + rr * 2) = (bf16)f2bf(v * rs * gg[e]); } }
    __syncthreads();
    const int pb = wid >> 1, cb0 = (wid & 1) * 2;
    f32x16 acc[2] = {};
#pragma unroll
    for (int ks = 0; ks < 8; ++ks) {
        const bf16x8 a = *(const bf16x8*)(lds + OFF_W + (pb * 32 + r32) * PITCH + (ks * 16 + hi * 8) * 2);
#pragma unroll
        for (int t = 0; t < 2; ++t) { const bf16x8 bv = *(const bf16x8*)(lds + OFF_V + ((cb0 + t) * 32 + r32) * PITCH + (ks * 16 + hi * 8) * 2);
            acc[t] = __builtin_amdgcn_mfma_f32_32x32x16_bf16(a, bv, acc[t], 0, 0, 0); }
    }
#pragma unroll
    for (int t = 0; t < 2; ++t)
#pragma unroll
        for (int r = 0; r < 16; ++r) { const int p = pb * 32 + (r & 3) + 8 * (r >> 2) + 4 * hi, c = (cb0 + t) * 32 + r32; const size_t row = (size_t)ch * 128 + p;
            const float sv = acc[t][r] + b_s[g * 128 + p];
            Y[row * D + g * 128 + c] = (bf16)f2bf(bf2f(UV[row * NUV + g * 128 + c]) * sv); }
}
}

constexpr int NWAVES = 8;
constexpr int RING_OFF = 0, RING_BYTES = 131072;
constexpr int LDSCTL_OFF = RING_BYTES, MISC_OFF = LDSCTL_OFF + 320;
constexpr int LDS_BYTES = 147456;
constexpr int CW_BAR = 4096;
typedef GAS unsigned gu32;
#define RLX_AGENT __ATOMIC_RELAXED, __HIP_MEMORY_SCOPE_AGENT
#define XB_TMO      128
#define XB_XCNT(j)  (256  + 64 * (j))
#define XB_XSUB(j)  (1280 + 64 * (j))
#define XB_XGEN(j)  (2304 + 64 * (j))
#define XB_TOP      3328
#define XB_TOPGEN   3392
#define XCD_BAR_WORDS 3456
#define XB_SPIN_CAP (1u << 18)
__device__ __forceinline__ unsigned xb_ld(unsigned* p)              { return __hip_atomic_load(p, __ATOMIC_RELAXED, __HIP_MEMORY_SCOPE_AGENT); }
__device__ __forceinline__ unsigned xb_add(unsigned* p, unsigned v) { return __hip_atomic_fetch_add(p, v, __ATOMIC_RELAXED, __HIP_MEMORY_SCOPE_AGENT); }
__device__ __forceinline__ unsigned xb_xcc_id() { return (unsigned)__builtin_amdgcn_s_getreg((3 << 11) | 20) & 0xFu; }
#define XB_SPIN(cond, bar) do { unsigned _sp = 0; while (cond) { __builtin_amdgcn_s_sleep(1); \
    if ((++_sp & 255u) == 0u) { if (xb_ld(&(bar)[XB_TMO])) break; if (_sp > XB_SPIN_CAP) { atomicAdd(&(bar)[XB_TMO], 1u); break; } } } } while (0)
struct XcdBarrier { unsigned* bar; unsigned x; volatile LAS unsigned* st; };
__device__ __forceinline__ XcdBarrier xcd_barrier_post(unsigned* bar, volatile LAS unsigned* st) {
    XcdBarrier b; b.bar = bar; b.x = xb_xcc_id(); b.st = st;
    if (threadIdx.x == 0) (void)xb_add(&bar[XB_XCNT(b.x)], 1u);
    return b;
}
__device__ __forceinline__ void xcd_barrier_complete(unsigned* bar, unsigned x, unsigned& nloc, unsigned& nx) {
    const unsigned G = gridDim.x * gridDim.y * gridDim.z;
    unsigned sum, cnt, mine, sp = 0u;
    for (;;) {
        sum = 0u; cnt = 0u; mine = 0u;
#pragma unroll
        for (unsigned j = 0; j < 16; ++j) { const unsigned c = xb_ld(&bar[XB_XCNT(j)]); sum += c; cnt += (c > 0u) ? 1u : 0u; mine = (j == x) ? c : mine; }
        if (sum == G) break;
        __builtin_amdgcn_s_sleep(1);
        if ((++sp & 255u) == 0u) { if (xb_ld(&bar[XB_TMO])) break; if (sp > XB_SPIN_CAP) { atomicAdd(&bar[XB_TMO], 1u); break; } }
    }
    nloc = mine > 0u ? mine : 1u; nx = cnt > 0u ? cnt : 1u;
}
__device__ __forceinline__ void xcd_barrier(const XcdBarrier& b) {
    asm volatile("s_waitcnt vmcnt(0)" ::: "memory");
    __syncthreads();
    if (threadIdx.x == 0) {
        unsigned* bar = b.bar;
        __builtin_amdgcn_s_waitcnt(0);
        unsigned nloc = b.st[0], nx = b.st[1];
        if (nloc == 0u) { xcd_barrier_complete(bar, b.x, nloc, nx); b.st[0] = nloc; b.st[1] = nx; }
        const unsigned old = xb_add(&bar[XB_XSUB(b.x)], 1u);
        const unsigned gen = old / nloc;
        if (old + 1u == (gen + 1u) * nloc) {
            __builtin_amdgcn_fence(__ATOMIC_RELEASE, "agent");
            asm volatile("s_waitcnt vmcnt(0)" ::: "memory");
            const unsigned og = xb_add(&bar[XB_TOP], 1u);
            const unsigned tg = og / nx;
            if (og + 1u == (tg + 1u) * nx) xb_add(&bar[XB_TOPGEN], 1u);
            else XB_SPIN(xb_ld(&bar[XB_TOPGEN]) == tg, bar);
            __builtin_amdgcn_fence(__ATOMIC_ACQUIRE, "agent");
            xb_add(&bar[XB_XGEN(b.x)], 1u);
            asm volatile("s_waitcnt vmcnt(0)" ::: "memory");
        } else {
            XB_SPIN(xb_ld(&bar[XB_XGEN(b.x)]) == gen, bar);
            __builtin_amdgcn_fence(__ATOMIC_ACQUIRE, "agent");
            asm volatile("s_waitcnt vmcnt(0)" ::: "memory");
        }
    }
    __syncthreads();
}

enum { PH_PRO = 0, PH_QKV, PH_DFT, PH_ATT, PH_WO0, PH_UP0, PH_DN0, PH_UV, PH_SGU, PH_WO1, PH_UP1, PH_DN1, PH_FIN, PH_N };
struct Args { const float* in[17]; float* out; unsigned char* ws; int ph_lo, ph_hi; };

__global__ void __launch_bounds__(NWAVES * 64, 2) mega(Args args) {
    extern __shared__ __attribute__((aligned(16))) unsigned char lds_raw[];
    LAS unsigned char* lds = (LAS unsigned char*)lds_raw;
    volatile LAS unsigned* MISC = (volatile LAS unsigned*)(lds + MISC_OFF);
    const int tid = threadIdx.x, lane = tid & 63, wave = __builtin_amdgcn_readfirstlane(tid >> 6);
    const int G = gridDim.x; const int bx = blockIdx.x; const int vcu = (G % 8 == 0) ? (bx % 8) * (G / 8) + bx / 8 : bx;
    unsigned char* ws = args.ws; float* out = args.out;
    const int lo = args.ph_lo, hi = args.ph_hi;
    for (int u = tid; u < (LDS_BYTES - LDSCTL_OFF) / 4; u += NWAVES * 64) ((LAS unsigned*)(lds + LDSCTL_OFF))[u] = 0u;
    __syncthreads();
    unsigned* barw = (unsigned*)(ws + WS_CTL) + CW_BAR + lo * XCD_BAR_WORDS;
    XcdBarrier bar; bar.bar = barw; bar.x = 0; bar.st = nullptr;
    if (hi - lo > 1) bar = xcd_barrier_post(barw, MISC + 8);
#ifndef PH_EN
#define PH_EN 0x1FFF
#endif
#define IN(k) (((PH_EN >> (k)) & 1) && lo <= (k) && (k) < hi)
#define SEAM(k) do { if (IN(k) && IN((k) + 1)) xcd_barrier(bar); } while (0)
    float* ssq = (float*)(ws + WS_SSQ);
#define SSQ(i) (ssq + (size_t)(i) * M * 16)
    const float* rstd0 = (const float*)(ws + WS_RSTD0);
    bf16* XB = (bf16*)(ws + WS_XB); bf16* QKV = (bf16*)((unsigned char*)out + OUT_QKV); bf16* ZfT = (bf16*)((unsigned char*)out + OUT_ZFT);
    bf16* Mix = (bf16*)(ws + WS_R1); bf16* Gb = (bf16*)(ws + WS_R1); bf16* UV = (bf16*)(ws + WS_R1); bf16* Y = (bf16*)(ws + WS_R2); bf16* Dm = (bf16*)(ws + WS_R2);
    bf16* Wqkv = (bf16*)(ws + WS_WQKV); bf16* Wf = (bf16*)(ws + WS_WF); bf16* Wo0 = (bf16*)(ws + WS_WO0); bf16* Wuv = (bf16*)(ws + WS_WUV); bf16* Wo1 = (bf16*)(ws + WS_WO1);

    if (IN(PH_PRO)) {
        ProArgs P; for (int i = 0; i < 17; ++i) P.in[i] = args.in[i]; P.ws = ws; P.out = out;
        prologue_body(P, lds, vcu * NWAVES + wave, G * NWAVES, lane, vcu * (NWAVES * 64) + tid, G * NWAVES * 64);
        SEAM(PH_PRO);
    }
    if (IN(PH_QKV)) {
        { GemmD g{XB, Wqkv, D, D, D, 6}; pg8::Order S; S.init(64, 6, G, bx, 0, D, D); EpiQKV E{QKV, rstd0};
          pg8::gemm_phase<EpiQKV, pg8::Order, true, true>(lds + RING_OFF, g, S, E); }
        { GemmD g{Wf, XB, D, D, D, 64}; pg8::Order S; S.init(2, 64, G, (bx + G / 2) % G, 0, D, D); EpiZfT E{ZfT, rstd0};
          pg8::gemm_phase<EpiZfT, pg8::Order, true, true>(lds + RING_OFF, g, S, E); }
        SEAM(PH_QKV);
    }
    if (IN(PH_DFT)) {
        GemmD g{Dm, ZfT, 4096, M, 4096, 8}; pg8::Order S; S.init(32, 8, G, bx, 1, 4096, M); EpiDft E{Mix};
        pg8::gemm_phase<EpiDft, pg8::Order, true, true>(lds + RING_OFF, g, S, E);
    }
    if (IN(PH_ATT)) {
        for (int un = vcu; un < NB * 4 * 16; un += G) { const int bh = un >> 4, qb = un & 15;
            att::attn_unit(bh >> 2, bh & 3, qb, QKV, (float*)(ws + WS_OSC), Mix, args.in[1], args.in[6], args.in[7], (char*)lds_raw + RING_OFF); }
        SEAM(PH_ATT);
    }
    if (IN(PH_WO0)) {
        GemmD g{Mix, Wo0, NMIX, NMIX, NMIX, 4}; pg8::Order S; S.init(64, 4, G, bx, 0, NMIX, NMIX); EpiResid E{args.in[0], out, XB, SSQ(1)};
        pg8::gemm_phase<EpiResid, pg8::Order, true, true>(lds + RING_OFF, g, S, E);
        SEAM(PH_WO0);
    }
#pragma unroll 1
    for (int L = 0; L < 2; ++L) {
        if (L == 1) {
            if (IN(PH_UV)) {
                GemmD g{XB, Wuv, D, D, D, 8}; pg8::Order S; S.init(64, 8, G, bx, 0, D, D); EpiUV E{UV, SSQ(2), SSQ(3)};
                pg8::gemm_phase<EpiUV, pg8::Order, true, true>(lds + RING_OFF, g, S, E);
                SEAM(PH_UV);
            }
            if (IN(PH_SGU)) {
                for (int un = vcu; un < 128 * 8; un += G) sgu::sgu_unit(un >> 3, un & 7, UV, (const bf16*)(ws + WS_WS), args.in[11], args.in[9], SSQ(3), Y, (char*)lds_raw + RING_OFF);
                __syncthreads();
                SEAM(PH_SGU);
            }
            if (IN(PH_WO1)) {
                GemmD g{Y, Wo1, D, D, D, 4}; pg8::Order S; S.init(64, 4, G, bx, 0, D, D); EpiResid E{out, out, XB, SSQ(4)};
                pg8::gemm_phase<EpiResid, pg8::Order, true, true>(lds + RING_OFF, g, S, E);
                SEAM(PH_WO1);
            }
        }
        const int pu = L == 0 ? PH_UP0 : PH_UP1, pd = L == 0 ? PH_DN0 : PH_DN1;
        if (IN(pu)) {
            GemmD g{XB, (const bf16*)(ws + WS_W13 + (size_t)L * 11 * MiB), D, D, D, 22}; pg8::Order S; S.init(64, 22, G, bx, 0, D, D); EpiFfnUp E{Gb, L == 0 ? SSQ(1) : SSQ(4)};
            pg8::gemm_phase<EpiFfnUp, pg8::Order, true, true>(lds + RING_OFF, g, S, E);
            SEAM(pu);
        }
        if (IN(pd)) {
            GemmD g{Gb, (const bf16*)(ws + WS_W2 + (size_t)L * (11 * MiB / 2)), FF, FF, FF, 4}; pg8::Order S; S.init(64, 4, G, bx, 0, FF, FF); EpiResid E{out, out, XB, L == 0 ? SSQ(2) : SSQ(5)};
            pg8::gemm_phase<EpiResid, pg8::Order, true, true>(lds + RING_OFF, g, S, E);
            SEAM(pd);
        }
    }
    if (IN(PH_FIN)) {
        const float* gfin = args.in[16]; const float* sp = SSQ(5);
        for (int row = vcu * NWAVES + wave; row < M; row += G * NWAVES) {
            const float r = rstd_from(sp, row);
            f32x4* o = (f32x4*)(out + (size_t)row * D) + lane; const f32x4* gg = (const f32x4*)gfin + lane;
#pragma unroll
            for (int j = 0; j < 4; ++j) { f32x4 v = o[64 * j]; const f32x4 gv = gg[64 * j]; v = v * r * gv; o[64 * j] = v; }
        }
    }
#undef IN
#undef SEAM
}

#ifndef FAST_MASK
#define FAST_MASK 0x1FFF
#endif
#ifndef SPLIT_LAUNCH
#define SPLIT_LAUNCH 0
#endif
extern "C" void kernel_launch(void* const* d_in, const int* in_sizes, int n_in, void* d_out, int out_size, void* d_ws, size_t ws_size, hipStream_t stream) {
    static int ok = 0;
    if (ok == 0) {
        if (n_in != 17 || in_sizes[0] != M * D || out_size != M * D || ws_size < WS_END) { fprintf(stderr, "kernel_launch: unexpected shapes (n_in %d, in0 %d, out %d, ws %zu)\n", n_in, n_in > 0 ? in_sizes[0] : -1, out_size, ws_size); ok = -1; return; }
        if (hipFuncSetAttribute((const void*)mega, hipFuncAttributeMaxDynamicSharedMemorySize, LDS_BYTES) != hipSuccess) { fprintf(stderr, "kernel_launch: hipFuncSetAttribute failed\n"); ok = -1; return; }
        int dev = 0, cus = 0;
        if (hipGetDevice(&dev) != hipSuccess || hipDeviceGetAttribute(&cus, hipDeviceAttributeMultiprocessorCount, dev) != hipSuccess || cus != 256) { fprintf(stderr, "kernel_launch: expected a 256-CU device, got %d\n", cus); ok = -1; return; }
        ok = 1;
    }
    if (ok < 0) return;
    unsigned char* ws = (unsigned char*)d_ws; float* out = (float*)d_out;
    Args a{}; for (int i = 0; i < 17; ++i) a.in[i] = (const float*)d_in[i]; a.out = out; a.ws = ws;
    float* ssq = (float*)(ws + WS_SSQ); auto SSQH = [&](int i) { return ssq + (size_t)i * M * 16; };
    const float* rstd0 = (const float*)(ws + WS_RSTD0);
    bf16* XB = (bf16*)(ws + WS_XB); bf16* QKV = (bf16*)((unsigned char*)d_out + OUT_QKV); bf16* ZfT = (bf16*)((unsigned char*)d_out + OUT_ZFT);
    bf16* Mix = (bf16*)(ws + WS_R1); bf16* G = (bf16*)(ws + WS_R1); bf16* UV = (bf16*)(ws + WS_R1); bf16* Y = (bf16*)(ws + WS_R2); bf16* Dm = (bf16*)(ws + WS_R2);
    bf16* Wqkv = (bf16*)(ws + WS_WQKV); bf16* Wf = (bf16*)(ws + WS_WF); bf16* Wo0 = (bf16*)(ws + WS_WO0); bf16* Wuv = (bf16*)(ws + WS_WUV); bf16* Wo1 = (bf16*)(ws + WS_WO1); bf16* Wsb = (bf16*)(ws + WS_WS);
    const float* x = a.in[0];
    (void)hipMemsetAsync(ws + WS_CTL, 0, CTL_ZERO_BYTES, stream);
    const unsigned fast = FAST_MASK;
    int p = 0;
    while (p < PH_N) {
        if ((fast >> p) & 1u) { int q = p; while (q < PH_N && ((fast >> q) & 1u)) { ++q; if (SPLIT_LAUNCH) break; }
            a.ph_lo = p; a.ph_hi = q; hipLaunchKernelGGL(mega, dim3(256), dim3(NWAVES * 64), LDS_BYTES, stream, a); p = q; continue; }
        switch (p) {
        case PH_QKV:
            { GemmD g{XB, Wqkv, D, D, D, 6}; EpiQKV E{QKV, rstd0}; hipLaunchKernelGGL((naive_gemm<EpiQKV, 0>), dim3(64 * 6 * 16), dim3(256), 0, stream, g, E); }
            { GemmD g{Wf, XB, D, D, D, 64}; EpiZfT E{ZfT, rstd0}; hipLaunchKernelGGL((naive_gemm<EpiZfT, 0>), dim3(2 * 64 * 16), dim3(256), 0, stream, g, E); } break;
        case PH_DFT: { GemmD g{Dm, ZfT, 4096, M, 4096, 8}; EpiDft E{Mix}; hipLaunchKernelGGL((naive_gemm<EpiDft, 1>), dim3(256 * 16), dim3(256), 0, stream, g, E); } break;
        case PH_ATT: hipLaunchKernelGGL(naive_attn, dim3(NB * 4 * SEQ), dim3(256), 0, stream, (const bf16*)QKV, Mix, a.in[1], a.in[6], a.in[7]); break;
        case PH_WO0: { GemmD g{Mix, Wo0, NMIX, NMIX, NMIX, 4}; EpiResid E{x, out, XB, nullptr}; hipLaunchKernelGGL((naive_gemm<EpiResid, 0>), dim3(256 * 16), dim3(256), 0, stream, g, E); }
            hipLaunchKernelGGL(naive_ssq<false>, dim3(M / 4), dim3(256), 0, stream, (const void*)out, D, 0, SSQH(1)); break;
        case PH_UV: { GemmD g{XB, Wuv, D, D, D, 8}; EpiUV E{UV, SSQH(2), nullptr}; hipLaunchKernelGGL((naive_gemm<EpiUV, 0>), dim3(64 * 8 * 16), dim3(256), 0, stream, g, E); }
            hipLaunchKernelGGL(naive_ssq<true>, dim3(M / 4), dim3(256), 0, stream, (const void*)UV, NUV, 1024, SSQH(3)); break;
        case PH_SGU: hipLaunchKernelGGL(naive_sgu, dim3(128 * 8 * 128), dim3(128), 0, stream, (const bf16*)UV, (const bf16*)Wsb, a.in[11], a.in[9], (const float*)SSQH(3), Y); break;
        case PH_WO1: { GemmD g{Y, Wo1, D, D, D, 4}; EpiResid E{out, out, XB, nullptr}; hipLaunchKernelGGL((naive_gemm<EpiResid, 0>), dim3(256 * 16), dim3(256), 0, stream, g, E); }
            hipLaunchKernelGGL(naive_ssq<false>, dim3(M / 4), dim3(256), 0, stream, (const void*)out, D, 0, SSQH(4)); break;
        case PH_UP0: case PH_UP1: { const int L = p == PH_UP1; GemmD g{XB, (const bf16*)(ws + WS_W13 + (size_t)L * 11 * MiB), D, D, D, 22}; EpiFfnUp E{G, L ? SSQH(4) : SSQH(1)};
            hipLaunchKernelGGL((naive_gemm<EpiFfnUp, 2>), dim3(64 * 22 * 8), dim3(256), 0, stream, g, E); } break;
        case PH_DN0: case PH_DN1: { const int L = p == PH_DN1; GemmD g{G, (const bf16*)(ws + WS_W2 + (size_t)L * (11 * MiB / 2)), FF, FF, FF, 4}; EpiResid E{out, out, XB, nullptr};
            hipLaunchKernelGGL((naive_gemm<EpiResid, 0>), dim3(256 * 16), dim3(256), 0, stream, g, E);
            hipLaunchKernelGGL(naive_ssq<false>, dim3(M / 4), dim3(256), 0, stream, (const void*)out, D, 0, L ? SSQH(5) : SSQH(2)); } break;
        case PH_FIN: hipLaunchKernelGGL(final_norm, dim3(M / 4), dim3(256), 0, stream, out, (const float*)SSQH(5), a.in[16]); break;
        default: break;
        }
        ++p;
    }
    const hipError_t le = hipPeekAtLastError();
    if (le != hipSuccess) fprintf(stderr, "kernel_launch: launch failed: %s\n", hipGetErrorName(le));
}
```
